# Optimizing an MI355X kernel written in HIP

```python
import math
import jax, jax.numpy as jnp
from jax import lax
import numpy as np

D_MODEL = 1024
BATCH = 32
SEQ = 2048
DEPTH = 1
DEC_BATCH = 16
DEC_SEQ = 16
PAST_LEN = 2048

CHUNK = 64
A_HEADS = 4
A_DK = 128
A_DV = 128
A_WIDTH = A_HEADS * A_DV
CONV_W = 4
B_HEADS = 8
B_DH = 64
B_WIDTH = B_HEADS * B_DH
BAND_CHUNKS = 8
BAND_PAST = BAND_CHUNKS * CHUNK
REL_MAX = 4 * CHUNK
REL_SIZE = REL_MAX + CHUNK
MIX_WIDTH = A_WIDTH + B_WIDTH
D_FF = 4 * D_MODEL
EPS = 1e-6

QA = 0
KA = QA + A_HEADS * A_DK
VA = KA + A_HEADS * A_DK
GA = VA + A_WIDTH
BA = GA + A_WIDTH
AA = BA + A_HEADS
QB = AA + A_HEADS
KB = QB + B_WIDTH
VB = KB + B_WIDTH
IN_COLS = VB + B_WIDTH
CONV_CH = GA - QA

kernel_name = "hybrid_gdn_chunkband_stream_step"


def rmsnorm(x, g):
    xf = x.astype(jnp.float32)
    y = xf * lax.rsqrt(jnp.mean(xf * xf, axis=-1, keepdims=True) + EPS)
    return (y * g.astype(jnp.float32)).astype(x.dtype)


def l2norm(x):
    xf = x.astype(jnp.float32)
    return xf * lax.rsqrt(jnp.sum(xf * xf, axis=-1, keepdims=True) + EPS)


def modulation(c, w_mod, b_mod):
    m = jax.nn.silu(c) @ w_mod + b_mod
    return jnp.split(m[:, None, :], 6, axis=-1)


def causal_conv_silu(u, left, w):
    full = jnp.concatenate([left.astype(u.dtype), u], axis=1)
    T = u.shape[1]
    out = full[:, 0:T] * w[0]
    for i in range(1, CONV_W):
        out = out + full[:, i:i + T] * w[i]
    return jax.nn.silu(out), full[:, full.shape[1] - (CONV_W - 1):]


def gated_delta_chunked(q, k, v, beta, g, s0):
    B, T, H, DK = q.shape
    DV = v.shape[-1]
    L = min(CHUNK, T)
    n = T // L

    def blk(x):
        x = x.astype(jnp.float32).reshape((B, n, L, H) + x.shape[3:])
        return jnp.moveaxis(x, (1, 3), (0, 2))

    q, k, v, beta, g = blk(q), blk(k), blk(v), blk(beta), blk(g)
    gc = jnp.cumsum(g, axis=-1)
    idx = jnp.arange(L)
    incl = idx[:, None] >= idx[None, :]
    strict = idx[:, None] > idx[None, :]
    decay = jnp.exp(jnp.where(incl, gc[..., :, None] - gc[..., None, :], -jnp.inf))
    kb = k * beta[..., None]
    m = jnp.where(strict, jnp.einsum('nbhid,nbhjd->nbhij', kb, k) * decay, 0.0)
    a = jnp.eye(L, dtype=jnp.float32) + m
    rhs = jnp.concatenate([v * beta[..., None], kb * jnp.exp(gc)[..., None]], axis=-1)
    sol = lax.linalg.triangular_solve(a, rhs, left_side=True, lower=True, unit_diagonal=True)
    u, w = sol[..., :DV], sol[..., DV:]
    qk = jnp.einsum('nbhid,nbhjd->nbhij', q, k) * decay

    def step(s, inp):
        qc, kc, uc, wc, qkc, gcc = inp
        vnew = uc - jnp.einsum('bhld,bhde->bhle', wc, s)
        o = (jnp.einsum('bhld,bhde->bhle', qc * jnp.exp(gcc)[..., None], s)
             + jnp.einsum('bhij,bhje->bhie', qkc, vnew))
        glast = gcc[..., -1]
        s = (s * jnp.exp(glast)[..., None, None]
             + jnp.einsum('bhld,bhle->bhde', kc * jnp.exp(glast[..., None] - gcc)[..., None], vnew))
        return s, o

    s, o = lax.scan(step, s0.astype(jnp.float32), (q, k, u, w, qk, gc))
    o = jnp.moveaxis(o, (0, 2), (1, 3)).reshape(B, T, H, DV)
    return o, s


def mixer_a(proj, conv_left, s0, conv_w, a_log, dt_bias, gdn_norm_g):
    B, T, _ = proj.shape
    qkv, conv_state = causal_conv_silu(proj[..., QA:GA], conv_left, conv_w)
    q = l2norm(qkv[..., QA:KA].reshape(B, T, A_HEADS, A_DK)) * (A_DK ** -0.5)
    k = l2norm(qkv[..., KA:VA].reshape(B, T, A_HEADS, A_DK))
    v = qkv[..., VA:GA].reshape(B, T, A_HEADS, A_DV)
    gate = proj[..., GA:BA].astype(jnp.float32).reshape(B, T, A_HEADS, A_DV)
    beta = jax.nn.sigmoid(proj[..., BA:AA].astype(jnp.float32))
    g = -jnp.exp(a_log.astype(jnp.float32)) * jax.nn.softplus(
        proj[..., AA:QB].astype(jnp.float32) + dt_bias.astype(jnp.float32))
    o, s = gated_delta_chunked(q, k, v, beta, g, s0)
    o = rmsnorm(o, gdn_norm_g) * jax.nn.silu(gate)
    return o.reshape(B, T, A_WIDTH).astype(proj.dtype), conv_state, s


def rel_bias_matrix(rel_bias, qpos, kpos):
    d = jnp.clip(qpos[:, None] - kpos[None, :], -(CHUNK - 1), REL_MAX) + (CHUNK - 1)
    return rel_bias.astype(jnp.float32)[:, d]


def band_attention_prompt(q, k, v, rel_bias):
    B, T, H, DH = q.shape
    n = T // CHUNK
    band = BAND_PAST + CHUNK
    pad = ((0, 0), (BAND_PAST, 0), (0, 0), (0, 0))
    kp, vp = jnp.pad(k, pad), jnp.pad(v, pad)
    j = jnp.arange(band)
    bias = rel_bias_matrix(rel_bias, jnp.arange(CHUNK) + BAND_PAST, j)

    def one_chunk(c):
        start = c * CHUNK
        qc = lax.dynamic_slice_in_dim(q, start, CHUNK, axis=1)
        kc = lax.dynamic_slice_in_dim(kp, start, band, axis=1)
        vc = lax.dynamic_slice_in_dim(vp, start, band, axis=1)
        valid = (start - BAND_PAST + j) >= 0
        s = jnp.einsum('bqhd,bkhd->bhqk', qc, kc).astype(jnp.float32) * (DH ** -0.5) + bias
        p = jax.nn.softmax(jnp.where(valid, s, -jnp.inf), axis=-1).astype(v.dtype)
        return jnp.einsum('bhqk,bkhd->bqhd', p, vc)

    o = lax.map(one_chunk, jnp.arange(n))
    return jnp.moveaxis(o, 0, 1).reshape(B, T, H * DH)


def band_attention_sample(q, k_new, v_new, k_cache, v_cache, rel_bias):
    B, T, H, DH = q.shape
    Lc = k_cache.shape[1]
    kk = jnp.concatenate([k_cache.astype(k_new.dtype), k_new], axis=1)
    vv = jnp.concatenate([v_cache.astype(v_new.dtype), v_new], axis=1)
    bias = rel_bias_matrix(rel_bias, jnp.arange(T) + Lc, jnp.arange(Lc + T))
    s = jnp.einsum('bqhd,bkhd->bhqk', q, kk).astype(jnp.float32) * (DH ** -0.5) + bias
    p = jax.nn.softmax(s, axis=-1).astype(vv.dtype)
    return jnp.einsum('bhqk,bkhd->bqhd', p, vv).reshape(B, T, H * DH)


def trunk_layer(x, c, conv_left, s0, band_cache, w_mod, b_mod, norm1_g, norm2_g, w_in, conv_w,
                a_log, dt_bias, gdn_norm_g, qn_g, kn_g, rel_bias, w_out, w_up, w_down):
    B, T, _ = x.shape
    sh1, sc1, g1, sh2, sc2, g2 = modulation(c, w_mod, b_mod)
    h = rmsnorm(x, norm1_g) * (1 + sc1) + sh1
    proj = h @ w_in
    if conv_left is None:
        conv_left = jnp.zeros((B, CONV_W - 1, CONV_CH), proj.dtype)
        s0 = jnp.zeros((B, A_HEADS, A_DK, A_DV), jnp.float32)
    o_a, conv_state, s = mixer_a(proj, conv_left, s0, conv_w, a_log, dt_bias, gdn_norm_g)
    qb = rmsnorm(proj[..., QB:KB].reshape(B, T, B_HEADS, B_DH), qn_g)
    kb = rmsnorm(proj[..., KB:VB].reshape(B, T, B_HEADS, B_DH), kn_g)
    vb = proj[..., VB:IN_COLS].reshape(B, T, B_HEADS, B_DH)
    if band_cache is None:
        o_b = band_attention_prompt(qb, kb, vb, rel_bias)
        keep = min(BAND_PAST, T)
        k_state, v_state = kb[:, T - keep:], vb[:, T - keep:]
    else:
        o_b = band_attention_sample(qb, kb, vb, band_cache[0], band_cache[1], rel_bias)
        k_state, v_state = kb, vb
    x = x + g1 * (jnp.concatenate([o_a, o_b], axis=-1) @ w_out)
    h = rmsnorm(x, norm2_g) * (1 + sc2) + sh2
    x = x + g2 * (jnp.square(jax.nn.relu(h @ w_up)) @ w_down)
    return x, conv_state, s, k_state, v_state


def setup_inputs(seed: int = 0) -> dict:
    key = jax.random.key(seed)
    ks = jax.random.split(key, 24)
    f32 = jnp.float32

    def nrm(k, shape, s):
        return jax.random.normal(k, shape, f32) * s

    band_len = min(BAND_PAST, PAST_LEN)
    dt = jnp.exp(jax.random.uniform(ks[16], (DEPTH, A_HEADS), f32, math.log(1e-3), math.log(1e-1)))
    return {
        "x_prompt": nrm(ks[0], (BATCH, SEQ, D_MODEL), 1.0),
        "x_sample": nrm(ks[1], (DEC_BATCH, DEC_SEQ, D_MODEL), 1.0),
        "state_conv": nrm(ks[2], (DEPTH, DEC_BATCH, CONV_W - 1, CONV_CH), 1.0),
        "state_gdn": nrm(ks[3], (DEPTH, DEC_BATCH, A_HEADS, A_DK, A_DV), 0.5),
        "cache_k_band": nrm(ks[4], (DEPTH, DEC_BATCH, band_len, B_HEADS, B_DH), 1.0),
        "cache_v_band": nrm(ks[5], (DEPTH, DEC_BATCH, band_len, B_HEADS, B_DH), 1.0),
        "c_prompt": nrm(ks[6], (BATCH, D_MODEL), 1.0),
        "c_sample": nrm(ks[7], (DEC_BATCH, D_MODEL), 1.0),
        "w_mod": nrm(ks[8], (DEPTH, D_MODEL, 6 * D_MODEL), D_MODEL ** -0.5),
        "b_mod": nrm(ks[9], (DEPTH, 6 * D_MODEL), 0.01),
        "norm1_g": 1.0 + nrm(ks[10], (DEPTH, D_MODEL), 0.1),
        "norm2_g": 1.0 + nrm(ks[11], (DEPTH, D_MODEL), 0.1),
        "w_in": nrm(ks[12], (DEPTH, D_MODEL, IN_COLS), D_MODEL ** -0.5),
        "conv_w": nrm(ks[13], (DEPTH, CONV_W, CONV_CH), CONV_W ** -0.5),
        "a_log": jnp.log(jax.random.uniform(ks[14], (DEPTH, A_HEADS), f32, 1.0, 16.0)),
        "dt_bias": dt + jnp.log(-jnp.expm1(-dt)),
        "gdn_norm_g": 1.0 + nrm(ks[15], (DEPTH, A_DV), 0.1),
        "qn_g": 1.0 + nrm(ks[17], (DEPTH, B_DH), 0.1),
        "kn_g": 1.0 + nrm(ks[18], (DEPTH, B_DH), 0.1),
        "rel_bias": nrm(ks[19], (DEPTH, B_HEADS, REL_SIZE), 0.5),
        "w_out": nrm(ks[20], (DEPTH, MIX_WIDTH, D_MODEL), MIX_WIDTH ** -0.5),
        "w_up": nrm(ks[21], (DEPTH, D_MODEL, D_FF), D_MODEL ** -0.5),
        "w_down": nrm(ks[22], (DEPTH, D_FF, D_MODEL), D_FF ** -0.5),
    }


def reference(x_prompt, x_sample, state_conv, state_gdn, cache_k_band, cache_v_band, c_prompt, c_sample,
              w_mod, b_mod, norm1_g, norm2_g, w_in, conv_w, a_log, dt_bias, gdn_norm_g, qn_g, kn_g,
              rel_bias, w_out, w_up, w_down):
    yp, ys = x_prompt, x_sample
    cp_l, gp_l, kp_l, vp_l, cs_l, gs_l, ks_l, vs_l = [], [], [], [], [], [], [], []
    for l in range(DEPTH):
        wl = (w_mod[l], b_mod[l], norm1_g[l], norm2_g[l], w_in[l], conv_w[l], a_log[l], dt_bias[l],
              gdn_norm_g[l], qn_g[l], kn_g[l], rel_bias[l], w_out[l], w_up[l], w_down[l])
        yp, cp, gp, kp, vp = trunk_layer(yp, c_prompt, None, None, None, *wl)
        ys, cs, gs, ksm, vsm = trunk_layer(ys, c_sample, state_conv[l], state_gdn[l],
                                           (cache_k_band[l], cache_v_band[l]), *wl)
        cp_l.append(cp); gp_l.append(gp); kp_l.append(kp); vp_l.append(vp)
        cs_l.append(cs); gs_l.append(gs); ks_l.append(ksm); vs_l.append(vsm)
    conv_prompt = jnp.stack(cp_l)
    gdn_prompt = jnp.stack(gp_l)
    kband_prompt = jnp.stack(kp_l)
    vband_prompt = jnp.stack(vp_l)
    conv_sample = jnp.stack(cs_l)
    gdn_sample = jnp.stack(gs_l)
    knew_sample = jnp.stack(ks_l)
    vnew_sample = jnp.stack(vs_l)
    return (yp, ys, conv_prompt, gdn_prompt, kband_prompt, vband_prompt,
            conv_sample, gdn_sample, knew_sample, vnew_sample)
```

```cpp
#include <hip/hip_runtime.h>
#include <hip/hip_cooperative_groups.h>
#include <cstdio>
#include <cstdint>
#include <utility>
namespace cg = cooperative_groups;
namespace pg8 {
#define PG8_LAS __attribute__((address_space(3)))
typedef unsigned short bf16_t;
typedef short bf16x8 __attribute__((ext_vector_type(8)));
typedef float f32x4 __attribute__((ext_vector_type(4)));
typedef unsigned u32x4 __attribute__((ext_vector_type(4)));
constexpr int BM = 256, BK = 64, HALF = 128, HTB = HALF * BK * 2  , STAGE_BYTES = 8 * HTB, NXCD = 8, WGM = 8;

__host__ __device__ __forceinline__ int lds_byte(int r, int c) { const int st = (r >> 4) * 2 + (c >> 5), rr = r & 15, cc = c & 31, ob = rr * 64 + cc * 2; return st * 1024 + (ob ^ (((ob >> 9) & 1) << 5)); }
__host__ __device__ __forceinline__ void stage_rc(int b, int& R, int& C) { const int st = b / 1024, sb = b % 1024, swz = sb ^ (((sb >> 9) & 1) << 5); R = (st >> 1) * 16 + swz / 64; C = (st & 1) * 32 + (swz % 64) / 2; }
__host__ __device__ __forceinline__ int perm32(int rho) { const int n = rho >> 4, i = rho & 15; return 8 * (i >> 2) + 4 * n + (i & 3); }

struct Unit { int pm, pn, kq; };
struct Gemm { const bf16_t* A; const bf16_t* Bt; int M, N, K; };

struct StaticOrder {
    int nM, nN, nwg, G, c;
    __host__ __device__ void init(int M, int N, int G_, int c_) { nM = M / BM; nN = N / BM; nwg = nM * nN; G = G_; c = c_; }
    __host__ __device__ bool next(int i, Unit& u) const {
        const long L = (long)i * G + c; if (L >= nwg) return false;
        int wgid = (int)L; { const int q = nwg / NXCD, r = nwg % NXCD, xcd = wgid % NXCD, off = wgid / NXCD; wgid = (xcd < r ? xcd * (q + 1) : r * (q + 1) + (xcd - r) * q) + off; }
        const int nig = WGM * nN, gid = wgid / nig, fm = gid * WGM, gsz = (nM - fm) < WGM ? (nM - fm) : WGM;
        u.pm = fm + ((wgid % nig) % gsz); u.pn = (wgid % nig) / gsz; u.kq = -1; return true;
    }
    __device__ __forceinline__ void a_ready(const Unit&) const {}
    __device__ __forceinline__ void done(const Unit&) const {}
};

struct SplitTailOrder {
    StaticOrder base; int nMp, nN;
    __host__ __device__ void init(int Mp, int N, int G_, int c_) { base.init(Mp, N, G_, c_); nMp = Mp / BM; nN = N / BM; }
    __host__ __device__ bool next(int i, Unit& u) const {
        const long L = (long)i * base.G + base.c;
        if (L < base.nwg) return base.next(i, u);
        const int s = (int)(L - base.nwg); if (s >= 4 * nN) return false;
        u.pm = nMp; u.pn = s % nN; u.kq = s / nN; return true;
    }
    __device__ __forceinline__ void a_ready(const Unit&) const {}
    __device__ __forceinline__ void done(const Unit&) const {}
};
template <class Epi, class Sched, bool ALIGN_EPI = false, bool SP2 = false>
__device__ __forceinline__ void gemm_phase(PG8_LAS unsigned char* lds, const Gemm g, const Sched& S, const Epi& E) {
    int tid_ = threadIdx.x; asm volatile("" : "+v"(tid_));
    const int tid = tid_, wid = __builtin_amdgcn_readfirstlane(tid >> 6), lane = tid & 63, wr = wid >> 2, wc = wid & 3, fr = lane & 15, fq = lane >> 4;
    const int K = g.K, nt = K / BK;
    unsigned voffA[2], voffB[2];
#pragma unroll
    for (int i = 0; i < 2; ++i) { int R, C; stage_rc(tid * 16 + i * 8192, R, C); const int Rb = Epi::PERM ? ((R & ~31) + perm32(R & 31)) : R;
        voffA[i] = (unsigned)(R * K + C) * 2u; voffB[i] = (unsigned)(Rb * K + C) * 2u; }
    const size_t kstep = (size_t)(BK * 2);
    const size_t hstep = (size_t)HALF * K * 2;
    const size_t tstep = 2 * hstep;
    const unsigned ldsw = (unsigned)wid * 1024u;
    const int aoff = lds_byte(wr * 64 + fr, fq * 8), boff = lds_byte(wc * 32 + fr, fq * 8);
#define PG8_SA(b, h) (((b) * 2 + (h)) * HTB)
#define PG8_SB(b, h) ((4 + (b) * 2 + (h)) * HTB)
#define PG8_STAGE(bufoff, gbase, voff) do { _Pragma("unroll") for (int _i = 0; _i < 2; ++_i) \
        __builtin_amdgcn_global_load_lds((const unsigned*)((const char*)(gbase) + (voff)[_i]), (PG8_LAS unsigned*)(lds + (bufoff) + ldsw + _i * 8192), 16, 0, 0); } while (0)
#define PG8_LDA(dst, b, h) do { _Pragma("unroll") for (int m = 0; m < 4; ++m) _Pragma("unroll") for (int k = 0; k < 2; ++k) dst[m][k] = *(const PG8_LAS bf16x8*)(lds + PG8_SA(b, h) + aoff + m * 2048 + k * 1024); } while (0)
#define PG8_LDB(dst, b, h) do { _Pragma("unroll") for (int n = 0; n < 2; ++n) _Pragma("unroll") for (int k = 0; k < 2; ++k) dst[n][k] = *(const PG8_LAS bf16x8*)(lds + PG8_SB(b, h) + boff + n * 2048 + k * 1024); } while (0)
#define PG8_MMA(ai, bj, At, Bt) do { __builtin_amdgcn_s_setprio(1); _Pragma("unroll") for (int m = 0; m < 4; ++m) _Pragma("unroll") for (int n = 0; n < 2; ++n) _Pragma("unroll") for (int k = 0; k < 2; ++k) \
        acc[ai][bj][m][n] = __builtin_amdgcn_mfma_f32_16x16x32_bf16(Bt[n][k], At[m][k], acc[ai][bj][m][n], 0, 0, 0); __builtin_amdgcn_s_setprio(0); } while (0)
#define PG8_WAIT_V(n) asm volatile("s_waitcnt vmcnt(" #n ")" ::: "memory")
#define PG8_WAIT_L(n) asm volatile("s_waitcnt lgkmcnt(" #n ")" ::: "memory")
#define PG8_BAR __builtin_amdgcn_s_barrier()
#define PG8_SCHED __builtin_amdgcn_sched_barrier(0)
    Unit cur, nxt; int ui = 0;
    if (!S.next(0, cur)) return;
    f32x4 acc[2][2][4][2];
#pragma unroll
    for (int a = 0; a < 2; ++a)
#pragma unroll
        for (int b = 0; b < 2; ++b)
#pragma unroll
            for (int m = 0; m < 4; ++m)
#pragma unroll
                for (int n = 0; n < 2; ++n) acc[a][b][m][n] = (f32x4){0.f, 0.f, 0.f, 0.f};
    bf16x8 At[4][2], B0[2][2], B1[2][2];
    const size_t qstep = (size_t)(K / 4) * 2;
    const char* cA = (const char*)g.A + (size_t)cur.pm * tstep + (cur.kq > 0 ? cur.kq * qstep : 0); const char* cB = (const char*)g.Bt + (size_t)cur.pn * tstep + (cur.kq > 0 ? cur.kq * qstep : 0);
    int cnt = cur.kq < 0 ? nt : nt / 4;
    S.a_ready(cur);
    if constexpr (SP2) {
        PG8_STAGE(PG8_SB(0, 0), cB, voffB); PG8_STAGE(PG8_SB(0, 1), cB + hstep, voffB); PG8_STAGE(PG8_SA(0, 0), cA, voffA); PG8_STAGE(PG8_SA(0, 1), cA + hstep, voffA);
        if (wr == 1) PG8_BAR;
        PG8_WAIT_V(2); PG8_BAR;
        PG8_STAGE(PG8_SB(1, 0), cB + kstep, voffB); PG8_STAGE(PG8_SA(1, 0), cA + kstep, voffA); PG8_STAGE(PG8_SB(1, 1), cB + hstep + kstep, voffB);
        PG8_WAIT_V(6); PG8_BAR;
    } else {
        PG8_STAGE(PG8_SB(0, 0), cB, voffB); PG8_STAGE(PG8_SA(0, 0), cA, voffA); PG8_STAGE(PG8_SB(0, 1), cB + hstep, voffB); PG8_STAGE(PG8_SA(0, 1), cA + hstep, voffA);
        if (wr == 1) PG8_BAR;
        PG8_WAIT_V(4); PG8_BAR;
        PG8_STAGE(PG8_SB(1, 0), cB + kstep, voffB); PG8_STAGE(PG8_SA(1, 0), cA + kstep, voffA); PG8_STAGE(PG8_SB(1, 1), cB + hstep + kstep, voffB);
        PG8_WAIT_V(6); PG8_BAR;
    }
    for (;;) {
        const bool has_next = S.next(ui + 1, nxt);
        const size_t nq = (has_next && nxt.kq > 0) ? nxt.kq * qstep : 0;
        const char* nA = has_next ? (const char*)g.A + (size_t)nxt.pm * tstep + nq : cA; const char* nB = has_next ? (const char*)g.Bt + (size_t)nxt.pn * tstep + nq : cB;
        for (int t = 0; t < cnt; t += 2) {
            const bool last = (t == cnt - 2);
            const char* a1 = cA + (size_t)(t + 1) * kstep;
            const char* a2 = last ? nA : cA + (size_t)(t + 2) * kstep; const char* b2 = last ? nB : cB + (size_t)(t + 2) * kstep;
            const char* a3 = a2 + kstep; const char* b3 = b2 + kstep;
            if (last && has_next) S.a_ready(nxt);
            if constexpr (SP2) {
            PG8_LDB(B0, 0, 0); PG8_LDB(B1, 0, 1); PG8_SCHED; PG8_LDA(At, 0, 0); PG8_STAGE(PG8_SA(1, 1), a1 + hstep, voffA);
            PG8_WAIT_V(8); PG8_WAIT_L(0); PG8_BAR; PG8_MMA(0, 0, At, B0); PG8_MMA(0, 1, At, B1); PG8_BAR; PG8_SCHED;
            PG8_LDA(At, 0, 1); PG8_STAGE(PG8_SB(0, 0), b2, voffB); PG8_STAGE(PG8_SB(0, 1), b2 + hstep, voffB); PG8_STAGE(PG8_SA(0, 0), a2, voffA);
            PG8_WAIT_V(8); PG8_WAIT_L(0); PG8_BAR; PG8_MMA(1, 0, At, B0); PG8_MMA(1, 1, At, B1); PG8_BAR; PG8_SCHED;
            PG8_LDB(B0, 1, 0); PG8_LDB(B1, 1, 1); PG8_SCHED; PG8_LDA(At, 1, 0); PG8_STAGE(PG8_SA(0, 1), a2 + hstep, voffA);
            PG8_WAIT_V(8); PG8_WAIT_L(0); PG8_BAR; PG8_MMA(0, 0, At, B0); PG8_MMA(0, 1, At, B1); PG8_BAR; PG8_SCHED;
            PG8_LDA(At, 1, 1); PG8_STAGE(PG8_SB(1, 0), b3, voffB); PG8_STAGE(PG8_SB(1, 1), b3 + hstep, voffB); PG8_STAGE(PG8_SA(1, 0), a3, voffA);
            PG8_WAIT_V(8); PG8_WAIT_L(0); PG8_BAR; PG8_MMA(1, 0, At, B0); PG8_MMA(1, 1, At, B1); PG8_BAR; PG8_SCHED;
            } else {
            PG8_LDB(B0, 0, 0); PG8_SCHED; PG8_LDA(At, 0, 0); PG8_STAGE(PG8_SA(1, 1), a1 + hstep, voffA);
            PG8_WAIT_L(8); PG8_BAR; PG8_WAIT_L(0); PG8_MMA(0, 0, At, B0); PG8_BAR; PG8_SCHED;
            PG8_LDB(B1, 0, 1); PG8_STAGE(PG8_SB(0, 0), b2, voffB);
            PG8_BAR; PG8_WAIT_L(0); PG8_MMA(0, 1, At, B1); PG8_BAR;
            PG8_LDA(At, 0, 1); PG8_STAGE(PG8_SA(0, 0), a2, voffA);
            PG8_BAR; PG8_WAIT_L(0); PG8_MMA(1, 0, At, B0); PG8_BAR; PG8_SCHED;
            PG8_STAGE(PG8_SB(0, 1), b2 + hstep, voffB);
            PG8_WAIT_V(6); PG8_BAR; PG8_MMA(1, 1, At, B1); PG8_BAR;
            PG8_LDB(B0, 1, 0); PG8_SCHED; PG8_LDA(At, 1, 0); PG8_STAGE(PG8_SA(0, 1), a2 + hstep, voffA);
            PG8_WAIT_L(8); PG8_BAR; PG8_WAIT_L(0); PG8_MMA(0, 0, At, B0); PG8_BAR; PG8_SCHED;
            PG8_LDB(B1, 1, 1); PG8_STAGE(PG8_SB(1, 0), b3, voffB);
            PG8_BAR; PG8_WAIT_L(0); PG8_MMA(0, 1, At, B1); PG8_BAR;
            PG8_LDA(At, 1, 1); PG8_STAGE(PG8_SA(1, 0), a3, voffA);
            PG8_BAR; PG8_WAIT_L(0); PG8_MMA(1, 0, At, B0); PG8_BAR; PG8_SCHED;
            PG8_STAGE(PG8_SB(1, 1), b3 + hstep, voffB);
            PG8_WAIT_V(6); PG8_BAR; PG8_MMA(1, 1, At, B1); PG8_BAR;
            }
        }
        if constexpr (ALIGN_EPI) { if (wr == 0) PG8_BAR; }
        if constexpr (!Epi::AFTER_DRAIN) { E(acc, cur, wr, wc, fr, fq); S.done(cur); }
        if (!has_next) break;
#pragma unroll
        for (int a = 0; a < 2; ++a)
#pragma unroll
            for (int b = 0; b < 2; ++b)
#pragma unroll
                for (int m = 0; m < 4; ++m)
#pragma unroll
                    for (int n = 0; n < 2; ++n) acc[a][b][m][n] = (f32x4){0.f, 0.f, 0.f, 0.f};
        cur = nxt; cA = nA; cB = nB; ++ui; cnt = cur.kq < 0 ? nt : nt / 4;
        if constexpr (ALIGN_EPI) { if (wr == 1) PG8_BAR; }
    }
    PG8_WAIT_V(0);
    if constexpr (!ALIGN_EPI) { if (wr == 0) PG8_BAR; }
    PG8_BAR;
    if constexpr (Epi::AFTER_DRAIN) { E.fused(acc, cur, wr, wc, fr, fq, lds, wid, lane); S.done(cur); }
#undef PG8_SA
#undef PG8_SB
#undef PG8_STAGE
#undef PG8_LDA
#undef PG8_LDB
#undef PG8_MMA
#undef PG8_WAIT_V
#undef PG8_WAIT_L
#undef PG8_BAR
#undef PG8_SCHED
}
}

#define LAS __attribute__((address_space(3)))
typedef unsigned short bf16_t;
typedef float f32x4 __attribute__((ext_vector_type(4)));
typedef float f32x2 __attribute__((ext_vector_type(2)));
typedef short bf16x8 __attribute__((ext_vector_type(8)));
typedef unsigned u32x4 __attribute__((ext_vector_type(4)));
typedef unsigned u32x2 __attribute__((ext_vector_type(2)));

constexpr int NTHREADS = 512;
constexpr int D = 1024, TP = 2048, MP = 65536, MS = 256, M = MP + MS, NPROJ = 3584, DFF = 4096, WIN_LD = 3592;
constexpr float EPS = 1e-6f, LOG2E = 1.4426950408889634f;
constexpr int C_QA = 0, C_KA = 512, C_VA = 1024, C_GA = 1536, C_QB = 2048, C_KB = 2560, C_VB = 3072;
constexpr size_t O_Y = 0, O_CONV_P = 67371008, O_GDN_P = 67518464, O_KB_P = 69615616, O_VB_P = 78004224,
                 O_CONV_S = 86392832, O_GDN_S = 86466560, O_KN_S = 87515136, O_VN_S = 87646208;
constexpr size_t MiB = 1u << 20;
constexpr size_t WS_CTL = 0, WS_WIN = 1 * MiB, WS_WOUT = 8 * MiB, WS_WUP = 10 * MiB, WS_WDN = 18 * MiB, WS_MOD = 26 * MiB, WS_BA = 28 * MiB,
                 WS_H = 32 * MiB, WS_MIX = 161 * MiB, WS_VT = 290 * MiB, WS_PROJ = 354 * MiB  , WS_X1B = 880 * MiB  , WS_END = 1010 * MiB;
constexpr int LDS_XB = 147456;
constexpr int LDS_BYTES = 147456 + 256;
constexpr int CW_BAR = 4096;

struct Params { const float* in[23]; float* out; unsigned char* ws; };

__device__ __forceinline__ unsigned cvt_pk_bf16(float lo, float hi) { unsigned r; asm volatile("v_cvt_pk_bf16_f32 %0, %1, %2" : "=v"(r) : "v"(lo), "v"(hi)); return r; }
__device__ __forceinline__ bf16_t f2bf(float f) { return (bf16_t)(cvt_pk_bf16(f, 0.f) & 0xffffu); }
__device__ __forceinline__ float bf2f(bf16_t h) { return __uint_as_float(((unsigned)h) << 16); }
__device__ __forceinline__ float wave_sum(float v) {
#pragma unroll
    for (int o = 1; o < 64; o <<= 1) v += __shfl_xor(v, o);
    return v;
}
__device__ __forceinline__ float wave_max(float v) {
#pragma unroll
    for (int o = 1; o < 64; o <<= 1) v = fmaxf(v, __shfl_xor(v, o));
    return v;
}
template <int CTRL> __device__ __forceinline__ float dpp_f(float v) { return __int_as_float(__builtin_amdgcn_update_dpp(0, __float_as_int(v), CTRL, 0xf, 0xf, true)); }
__device__ __forceinline__ float wave_sum_u(float v) {
    v += dpp_f<0x111>(v); v += dpp_f<0x112>(v); v += dpp_f<0x114>(v); v += dpp_f<0x118>(v);
    const int iv = __float_as_int(v);
    return (__int_as_float(__builtin_amdgcn_readlane(iv, 15)) + __int_as_float(__builtin_amdgcn_readlane(iv, 31))) + (__int_as_float(__builtin_amdgcn_readlane(iv, 47)) + __int_as_float(__builtin_amdgcn_readlane(iv, 63)));
}
template <int N> __device__ __forceinline__ void fmac_bc(float& s, float mv, float xj) { asm("v_fmac_f32_dpp %0, %1, %2 row_newbcast:%3 row_mask:0xf bank_mask:0xf bound_ctrl:1" : "+v"(s) : "v"(mv), "v"(xj), "n"(N)); }
__device__ __forceinline__ int opq(int v) { asm volatile("" : "+v"(v)); return v; }
__device__ __forceinline__ int row_batch(int row) { return row < MP ? (row >> 11) : 32 + ((row - MP) >> 4); }
__device__ __forceinline__ float silu_f(float x) { return x * __builtin_amdgcn_rcpf(1.f + __builtin_amdgcn_exp2f(-LOG2E * x)); }
__device__ __forceinline__ float sigmoid_f(float x) { return __builtin_amdgcn_rcpf(1.f + __builtin_amdgcn_exp2f(-LOG2E * x)); }
__device__ __forceinline__ int perm_pos(int c) { return ((c >> 5) & 1) * 128 + (c >> 6) * 32 + ((c >> 2) & 1) * 16 + ((c >> 3) & 3) * 4 + (c & 3); }

__device__ __forceinline__ void transpose_item(const float* W, int ldw, int K, int N, bool skip8, bf16_t* WT, LAS float* scr, int item, int lane) {
    const int nblk = N / 64, kb = item / nblk, nb = item % nblk, k0 = 64 * kb, n0 = 64 * nb;
    const int soff = (skip8 && n0 >= 2048) ? 8 : 0;
#pragma unroll 8
    for (int i = 0; i < 64; ++i) scr[i * 65 + lane] = W[(size_t)(k0 + i) * ldw + soff + n0 + lane];
    asm volatile("s_waitcnt lgkmcnt(0)" ::: "memory");
    const int c = lane & 7;
#pragma unroll
    for (int j = 0; j < 8; ++j) { const int n = (lane >> 3) + 8 * j; const LAS float* s = scr + (8 * c) * 65 + n;
        u32x4 o; o.x = cvt_pk_bf16(s[0 * 65], s[1 * 65]); o.y = cvt_pk_bf16(s[2 * 65], s[3 * 65]); o.z = cvt_pk_bf16(s[4 * 65], s[5 * 65]); o.w = cvt_pk_bf16(s[6 * 65], s[7 * 65]);
        const int col = n0 + n, drow = (col & ~255) + perm_pos(col & 255);
        *(u32x4*)(WT + (size_t)drow * K + k0 + 8 * c) = o; }
    asm volatile("s_waitcnt lgkmcnt(0)" ::: "memory");
}

template <int... E> __device__ __forceinline__ void mod_fma16(float& acc, float scv, const float (&w)[16], std::integer_sequence<int, E...>) { (fmac_bc<E>(acc, scv, w[E]), ...); }
__device__ __forceinline__ void mod_item(const Params& p, LAS unsigned char* L, int jb, int tid) {
    LAS float* sc = (LAS float*)L;
    LAS float* red = (LAS float*)L;
    const int jj = tid & 31, kg = tid >> 5, j0 = jb * 32;
    const float* cp = p.in[6]; const float* cs = p.in[7]; const float* wm = p.in[8]; const float* bm = p.in[9];
    float* MOD = (float*)(p.ws + WS_MOD);
    float acc[48];
#pragma unroll
    for (int b = 0; b < 48; ++b) acc[b] = 0.f;
    for (int kc = 0; kc < 4; ++kc) {
        __syncthreads();
        for (int i = tid; i < 48 * 256; i += NTHREADS) { const int b = i >> 8, kk = i & 255; const float c = (b < 32) ? cp[b * 1024 + kc * 256 + kk] : cs[(b - 32) * 1024 + kc * 256 + kk]; sc[i] = silu_f(c); }
        __syncthreads();
        {
            float w[16];
#pragma unroll
            for (int e = 0; e < 16; ++e) w[e] = wm[(size_t)(kc * 256 + 16 * kg + e) * 6144 + j0 + jj];
#pragma unroll
            for (int b = 0; b < 48; ++b) { const float scv = sc[b * 256 + 16 * kg + (tid & 15)]; mod_fma16(acc[b], scv, w, std::make_integer_sequence<int, 16>{}); }
        }
    }
    __syncthreads();
#pragma unroll
    for (int b = 0; b < 48; ++b) red[(kg * 48 + b) * 32 + jj] = acc[b];
    __syncthreads();
    for (int i = tid; i < 48 * 32; i += NTHREADS) { const int b = i >> 5, j = i & 31; float s = 0.f;
#pragma unroll
        for (int k = 0; k < 16; ++k) s += red[(k * 48 + b) * 32 + j];
        MOD[b * 6144 + j0 + j] = s + bm[j0 + j]; }
    __syncthreads();
}

__device__ __forceinline__ void phase0(const Params& p, LAS unsigned char* L, int tid, int wave, int lane) {
    constexpr int I_IN = 16 * 56, I_OUT = 16 * 16, I_UP = 16 * 64, I_DN = 64 * 16, NIT = I_IN + I_OUT + I_UP + I_DN, NGRP = NIT / 8, NMOD = 192;
    unsigned* ctr = (unsigned*)(p.ws + WS_CTL) + 1;
    volatile LAS int* sitem = (volatile LAS int*)(L + 142336);
    LAS float* scr = (LAS float*)(L + wave * 16640);
    for (;;) {
        if (tid == 0) *sitem = (int)atomicAdd(ctr, 1u);
        __syncthreads();
        const int it = *sitem;
        __syncthreads();
        if (it >= NMOD + NGRP) break;
        if (it < NMOD) { mod_item(p, L, it, tid); continue; }
        int r = (it - NMOD) * 8 + wave;
        if (r < I_IN) { transpose_item(p.in[12], WIN_LD, D, NPROJ, true, (bf16_t*)(p.ws + WS_WIN), scr, r, lane); continue; } r -= I_IN;
        if (r < I_OUT) { transpose_item(p.in[20], D, D, D, false, (bf16_t*)(p.ws + WS_WOUT), scr, r, lane); continue; } r -= I_OUT;
        if (r < I_UP) { transpose_item(p.in[21], DFF, D, DFF, false, (bf16_t*)(p.ws + WS_WUP), scr, r, lane); continue; } r -= I_UP;
        transpose_item(p.in[22], D, DFF, D, false, (bf16_t*)(p.ws + WS_WDN), scr, r, lane);
    }
}

template <bool FIRST>
__device__ __forceinline__ void prepass(const Params& p, LAS unsigned char* L, int tid, int wave, int lane) {
    const float* MOD = (const float*)(p.ws + WS_MOD);
    bf16_t* H = (bf16_t*)(p.ws + WS_H);
    float* BA = (float*)(p.ws + WS_BA);
    LAS float* wba = (LAS float*)L;
    if (FIRST) {
        const float* win = p.in[12];
        for (int i = tid; i < 8192; i += NTHREADS) { const int k = i >> 3, c = i & 7; wba[c * 1024 + k] = win[(size_t)k * WIN_LD + 2048 + c]; }
        __syncthreads();
    }
    const float* gn = FIRST ? p.in[10] : p.in[11];
    const int shoff = FIRST ? 0 : 3072, scoff = FIRST ? 1024 : 4096;
    f32x4 g[4];
#pragma unroll
    for (int j = 0; j < 4; ++j) g[j] = *(const f32x4*)(gn + 4 * lane + 256 * j);
    const int gw = blockIdx.x * 8 + wave, NGW = gridDim.x * 8;
    const bf16_t* X1B = (const bf16_t*)(p.ws + WS_X1B);
    auto ldrow = [&](int row, int j) -> f32x4 {
        if (FIRST) { const float* xr = row < MP ? p.in[0] + (size_t)row * D : p.in[1] + (size_t)(row - MP) * D; return *(const f32x4*)(xr + 4 * lane + 256 * j); }
        const u32x2 w = *(const u32x2*)(X1B + (size_t)row * D + 4 * lane + 256 * j);
        return (f32x4){__uint_as_float(w.x << 16), __uint_as_float(w.x & 0xffff0000u), __uint_as_float(w.y << 16), __uint_as_float(w.y & 0xffff0000u)}; };
    f32x4 vn[4];
    if (gw < M) {
#pragma unroll
        for (int j = 0; j < 4; ++j) vn[j] = ldrow(gw, j);
    }
    for (int row = gw; row < M; row += NGW) {
        const int b = row_batch(row);
        f32x4 v[4]; float ss = 0.f;
#pragma unroll
        for (int j = 0; j < 4; ++j) { v[j] = vn[j]; ss += (v[j].x * v[j].x + v[j].y * v[j].y) + (v[j].z * v[j].z + v[j].w * v[j].w); }
        if (row + NGW < M) {
#pragma unroll
            for (int j = 0; j < 4; ++j) vn[j] = ldrow(row + NGW, j);
        }
        const float rstd = rsqrtf(wave_sum_u(ss) * (1.f / D) + EPS);
        const float* mb = MOD + (size_t)b * 6144;
#pragma unroll
        for (int j = 0; j < 4; ++j) { const f32x4 sc = *(const f32x4*)(mb + scoff + 4 * lane + 256 * j), sh = *(const f32x4*)(mb + shoff + 4 * lane + 256 * j);
            v[j] = v[j] * rstd * g[j] * (sc + 1.f) + sh;
            u32x2 w; w.x = cvt_pk_bf16(v[j].x, v[j].y); w.y = cvt_pk_bf16(v[j].z, v[j].w);
            *(u32x2*)(H + (size_t)row * D + 4 * lane + 256 * j) = w; }
        if (FIRST) {
            float mine = 0.f;
#pragma unroll
            for (int c = 0; c < 8; ++c) { float s = 0.f;
#pragma unroll
                for (int j = 0; j < 4; ++j) { const f32x4 w = *(const LAS f32x4*)(wba + c * 1024 + 4 * lane + 256 * j); s += (v[j].x * w.x + v[j].y * w.y) + (v[j].z * w.z + v[j].w * w.w); }
                s = wave_sum_u(s); if (lane == c) mine = s; }
            if (lane < 8) BA[(size_t)row * 8 + lane] = mine;
        }
    }
}

struct EpiIn {
    static constexpr bool PERM = false, AFTER_DRAIN = false;
    bf16_t* proj; bf16_t* vt; const float* qn_g; const float* kn_g; float* out; LAS unsigned char* xl;
    __device__ __forceinline__ void operator()(const f32x4 (&acc)[2][2][4][2], const pg8::Unit& u, int wr, int wc, int fr, int fq) const {
        const int grp = u.pn >> 1;
        const int col0 = u.pn * 256 + wc * 64 + fq * 8;
        const bool samp = (u.pm == 256);
        const bool nrm = (grp == 4 || grp == 5);
        f32x4 gq[2][2];
        if (nrm) { const float* gp = (grp == 4) ? qn_g : kn_g; const float scl = (grp == 4) ? 0.125f * LOG2E : 1.f;
#pragma unroll
            for (int bj = 0; bj < 2; ++bj)
#pragma unroll
                for (int n = 0; n < 2; ++n) gq[bj][n] = *(const f32x4*)(gp + bj * 32 + fq * 8 + n * 4) * scl; }
#pragma unroll
        for (int ai = 0; ai < 2; ++ai)
#pragma unroll
            for (int m = 0; m < 4; ++m) {
                const int row = u.pm * 256 + ai * 128 + wr * 64 + m * 16 + fr;
                f32x4 v[2][2];
#pragma unroll
                for (int bj = 0; bj < 2; ++bj)
#pragma unroll
                    for (int n = 0; n < 2; ++n) v[bj][n] = acc[ai][bj][m][n];
                if (nrm) {
                    float ss = 0.f;
#pragma unroll
                    for (int bj = 0; bj < 2; ++bj)
#pragma unroll
                        for (int n = 0; n < 2; ++n) ss += (v[bj][n].x * v[bj][n].x + v[bj][n].y * v[bj][n].y) + (v[bj][n].z * v[bj][n].z + v[bj][n].w * v[bj][n].w);
                    ss += __shfl_xor(ss, 16); ss += __shfl_xor(ss, 32);
                    const float rstd = rsqrtf(ss * (1.f / 64.f) + EPS);
#pragma unroll
                    for (int bj = 0; bj < 2; ++bj)
#pragma unroll
                        for (int n = 0; n < 2; ++n) v[bj][n] = v[bj][n] * rstd * gq[bj][n];
                }
                bf16_t* pr = proj + (size_t)row * NPROJ + col0;
#pragma unroll
                for (int bj = 0; bj < 2; ++bj) { u32x4 w; w.x = cvt_pk_bf16(v[bj][0].x, v[bj][0].y); w.y = cvt_pk_bf16(v[bj][0].z, v[bj][0].w); w.z = cvt_pk_bf16(v[bj][1].x, v[bj][1].y); w.w = cvt_pk_bf16(v[bj][1].z, v[bj][1].w);
                    *(u32x4*)(pr + bj * 32) = w; }
                int b, t; if (!samp) { b = row >> 11; t = row & 2047; } else { b = (row - MP) >> 4; t = (row - MP) & 15; }
                if (grp <= 2) {
                    const int tl = samp ? t - 13 : t - 2045;
                    if (tl >= 0) { float* o = out + (samp ? O_CONV_S : O_CONV_P) + ((size_t)b * 3 + tl) * 1536 + col0;
#pragma unroll
                        for (int bj = 0; bj < 2; ++bj)
#pragma unroll
                            for (int n = 0; n < 2; ++n) *(f32x4*)(o + bj * 32 + n * 4) = v[bj][n]; }
                } else if (grp >= 5) {
                    const int cc = col0 - (grp == 5 ? C_KB : C_VB);
                    if (!samp) {
                        if (t >= 1536) { float* o = out + (grp == 5 ? O_KB_P : O_VB_P) + ((size_t)b * 512 + (t - 1536)) * 512 + cc;
#pragma unroll
                            for (int bj = 0; bj < 2; ++bj)
#pragma unroll
                                for (int n = 0; n < 2; ++n) *(f32x4*)(o + bj * 32 + n * 4) = v[bj][n]; }
                        if (grp == 6) {
                            LAS bf16_t* tb = (LAS bf16_t*)(xl + (wr * 4 + wc) * 2048);
#pragma unroll
                            for (int bj = 0; bj < 2; ++bj)
#pragma unroll
                                for (int n = 0; n < 2; ++n)
#pragma unroll
                                    for (int j = 0; j < 4; ++j) tb[(bj * 32 + fq * 8 + n * 4 + j) * 16 + fr] = f2bf(v[bj][n][j]);
                            asm volatile("s_waitcnt lgkmcnt(0)" ::: "memory");
                            const int ln = fq * 16 + fr;
                            const u32x4 lo = *(const LAS u32x4*)(tb + ln * 16), hi = *(const LAS u32x4*)(tb + ln * 16 + 8);
                            bf16_t* vp = vt + ((size_t)b * 512 + (cc - fq * 8) + ln) * 2048 + (t - fr);
                            *(u32x4*)vp = lo; *(u32x4*)(vp + 8) = hi;
                            asm volatile("s_waitcnt lgkmcnt(0)" ::: "memory");
                        }
                    } else { float* o = out + (grp == 5 ? O_KN_S : O_VN_S) + ((size_t)b * 16 + t) * 512 + cc;
#pragma unroll
                        for (int bj = 0; bj < 2; ++bj)
#pragma unroll
                            for (int n = 0; n < 2; ++n) *(f32x4*)(o + bj * 32 + n * 4) = v[bj][n]; }
                }
            }
    }
};
template <bool INPLACE>
struct EpiRes {
    static constexpr bool PERM = false, AFTER_DRAIN = false;
    const float* xp; const float* xs; const float* mod; int goff; float* out; bf16_t* x1b;
    __device__ __forceinline__ void operator()(const f32x4 (&acc)[2][2][4][2], const pg8::Unit& u, int wr, int wc, int fr, int fq) const {
        const int col0 = u.pn * 256 + wc * 64 + fq * 8;
#pragma unroll
        for (int ai = 0; ai < 2; ++ai)
#pragma unroll
            for (int m = 0; m < 4; ++m) {
                const int row = u.pm * 256 + ai * 128 + wr * 64 + m * 16 + fr;
                const int b = row_batch(row);
                float* o = out + (size_t)row * D + col0;
                bf16_t* xb = x1b + (size_t)row * D + col0;
                const float* gp = mod + (size_t)b * 6144 + goff + col0;
#pragma unroll
                for (int bj = 0; bj < 2; ++bj) {
                    const f32x4 g0 = *(const f32x4*)(gp + bj * 32), g1 = *(const f32x4*)(gp + bj * 32 + 4);
                    if (INPLACE) {
                        if (u.kq >= 0) {
                            const f32x4 d0 = g0 * acc[ai][bj][m][0], d1 = g1 * acc[ai][bj][m][1]; float* q = o + bj * 32;
                            unsafeAtomicAdd(q, d0.x); unsafeAtomicAdd(q + 1, d0.y); unsafeAtomicAdd(q + 2, d0.z); unsafeAtomicAdd(q + 3, d0.w);
                            unsafeAtomicAdd(q + 4, d1.x); unsafeAtomicAdd(q + 5, d1.y); unsafeAtomicAdd(q + 6, d1.z); unsafeAtomicAdd(q + 7, d1.w);
                        } else {
                            const u32x4 w = *(const u32x4*)(xb + bj * 32);
                            const f32x4 x0 = (f32x4){__uint_as_float(w.x << 16), __uint_as_float(w.x & 0xffff0000u), __uint_as_float(w.y << 16), __uint_as_float(w.y & 0xffff0000u)};
                            const f32x4 x1 = (f32x4){__uint_as_float(w.z << 16), __uint_as_float(w.z & 0xffff0000u), __uint_as_float(w.w << 16), __uint_as_float(w.w & 0xffff0000u)};
                            *(f32x4*)(o + bj * 32) = x0 + g0 * acc[ai][bj][m][0]; *(f32x4*)(o + bj * 32 + 4) = x1 + g1 * acc[ai][bj][m][1];
                        }
                    } else {
                        const float* base = (row < MP ? xp + (size_t)row * D : xs + (size_t)(row - MP) * D) + col0 + bj * 32;
                        const f32x4 y0 = *(const f32x4*)base + g0 * acc[ai][bj][m][0], y1 = *(const f32x4*)(base + 4) + g1 * acc[ai][bj][m][1];
                        u32x4 w; w.x = cvt_pk_bf16(y0.x, y0.y); w.y = cvt_pk_bf16(y0.z, y0.w); w.z = cvt_pk_bf16(y1.x, y1.y); w.w = cvt_pk_bf16(y1.z, y1.w);
                        *(u32x4*)(xb + bj * 32) = w;
                        if (u.pm == 256) { *(f32x4*)(o + bj * 32) = y0; *(f32x4*)(o + bj * 32 + 4) = y1; }
                    }
                }
            }
    }
};
struct EpiUp {
    static constexpr bool PERM = false, AFTER_DRAIN = false;
    bf16_t* hid;
    __device__ __forceinline__ void operator()(const f32x4 (&acc)[2][2][4][2], const pg8::Unit& u, int wr, int wc, int fr, int fq) const {
        const int col0 = u.pn * 256 + wc * 64 + fq * 8;
#pragma unroll
        for (int ai = 0; ai < 2; ++ai)
#pragma unroll
            for (int m = 0; m < 4; ++m) {
                const int row = u.pm * 256 + ai * 128 + wr * 64 + m * 16 + fr;
                bf16_t* o = hid + (size_t)row * DFF + col0;
#pragma unroll
                for (int bj = 0; bj < 2; ++bj) { f32x4 a = acc[ai][bj][m][0], c = acc[ai][bj][m][1];
                    a = __builtin_elementwise_max(a, (f32x4){0.f, 0.f, 0.f, 0.f}); c = __builtin_elementwise_max(c, (f32x4){0.f, 0.f, 0.f, 0.f}); a = a * a; c = c * c;
                    u32x4 w; w.x = cvt_pk_bf16(a.x, a.y); w.y = cvt_pk_bf16(a.z, a.w); w.z = cvt_pk_bf16(c.x, c.y); w.w = cvt_pk_bf16(c.z, c.w);
                    *(u32x4*)(o + bj * 32) = w; }
            }
    }
};

constexpr int G_RAW = 0, G_QS = 29184, G_KS = G_QS + 8192, G_VS = G_KS + 8192, G_OS = G_VS + 8192, G_PART = G_OS + 8192, G_CW = G_PART + 8192, G_SA = G_CW + 6144, G_SB = G_SA + 64, G_QK = G_SB + 64;
__device__ __forceinline__ void gdn_item(const Params& p, LAS unsigned char* L, int rowbase, int T, int h, const float* s0, const float* left, float* sout, int tid_in, int wave, int lane_in) {
    const int tid = opq(tid_in), lane = tid & 63;
    const bf16_t* proj = (const bf16_t*)(p.ws + WS_PROJ);
    const float* BA = (const float*)(p.ws + WS_BA);
    bf16_t* mix = (bf16_t*)(p.ws + WS_MIX);
    LAS float* raw = (LAS float*)(L + G_RAW); LAS float* qs = (LAS float*)(L + G_QS); LAS float* ks = (LAS float*)(L + G_KS); LAS float* vs = (LAS float*)(L + G_VS);
    LAS float* os = (LAS float*)(L + G_OS); LAS f32x2* part = (LAS f32x2*)(L + G_PART); LAS float* cw = (LAS float*)(L + G_CW);
    LAS float* sa = (LAS float*)(L + G_SA); LAS float* sb = (LAS float*)(L + G_SB); LAS float* sqk = (LAS float*)(L + G_QK);
    const int dv = tid & 127, kg = tid >> 7;
    float S[32];
#pragma unroll
    for (int i = 0; i < 32; ++i) S[i] = s0 ? s0[(size_t)(kg * 32 + i) * 128 + dv] : 0.f;
    const float* convw = p.in[13];
    for (int i = tid; i < 4 * 384; i += NTHREADS) { const int tap = i / 384, ch = i % 384; cw[i] = convw[tap * 1536 + (ch >> 7) * 512 + h * 128 + (ch & 127)]; }
    const float nAexp = -__expf(p.in[14][h]), dtb = p.in[15][h];
    const float gn0 = p.in[16][lane], gn1 = p.in[16][lane + 64];
    int buf = 0;
    for (int t0 = 0; t0 < T; t0 += 16) {
        for (int i = tid; i < 19 * 48; i += NTHREADS) {
            const int r = i / 48, seg = i % 48, part_ = seg >> 4, off = (seg & 15) * 8, t = t0 - 3 + r;
            float v8[8];
            if (t >= 0) { const u32x4 w = *(const u32x4*)(proj + (size_t)(rowbase + t) * NPROJ + part_ * 512 + h * 128 + off);
                v8[0] = __uint_as_float(w.x << 16); v8[1] = __uint_as_float(w.x & 0xffff0000u); v8[2] = __uint_as_float(w.y << 16); v8[3] = __uint_as_float(w.y & 0xffff0000u);
                v8[4] = __uint_as_float(w.z << 16); v8[5] = __uint_as_float(w.z & 0xffff0000u); v8[6] = __uint_as_float(w.w << 16); v8[7] = __uint_as_float(w.w & 0xffff0000u); }
            else if (left) { const float* lp = left + (size_t)(3 + t) * 1536 + part_ * 512 + h * 128 + off;
#pragma unroll
                for (int e = 0; e < 8; ++e) v8[e] = lp[e]; }
            else {
#pragma unroll
                for (int e = 0; e < 8; ++e) v8[e] = 0.f; }
            LAS float* d = raw + r * 384 + part_ * 128 + off;
            *(LAS f32x4*)d = (f32x4){v8[0], v8[1], v8[2], v8[3]}; *(LAS f32x4*)(d + 4) = (f32x4){v8[4], v8[5], v8[6], v8[7]};
        }
        __syncthreads();
        for (int i = tid; i < 16 * 384; i += NTHREADS) {
            const int tok = i / 384, ch = i % 384;
            const float a = cw[ch] * raw[tok * 384 + ch] + cw[384 + ch] * raw[(tok + 1) * 384 + ch] + cw[768 + ch] * raw[(tok + 2) * 384 + ch] + cw[1152 + ch] * raw[(tok + 3) * 384 + ch];
            const float y = silu_f(a);
            LAS float* dst = (ch < 128) ? qs : (ch < 256 ? ks : vs);
            dst[tok * 128 + (ch & 127)] = y;
        }
        __syncthreads();
#pragma unroll
        for (int rr = 0; rr < 2; ++rr) {
            const int tok = wave + 8 * rr;
            const float q0 = qs[tok * 128 + lane], q1 = qs[tok * 128 + lane + 64], k0 = ks[tok * 128 + lane], k1 = ks[tok * 128 + lane + 64];
            const float sq = wave_sum(q0 * q0 + q1 * q1), sk = wave_sum(k0 * k0 + k1 * k1), qk = wave_sum(q0 * k0 + q1 * k1);
            const float rq = rsqrtf(sq + EPS) * 0.08838834764831845f, rk = rsqrtf(sk + EPS);
            qs[tok * 128 + lane] = q0 * rq; qs[tok * 128 + lane + 64] = q1 * rq; ks[tok * 128 + lane] = k0 * rk; ks[tok * 128 + lane + 64] = k1 * rk;
            if (lane == 0) {
                const size_t row = (size_t)(rowbase + t0 + tok);
                const float braw = BA[row * 8 + h], araw = BA[row * 8 + 4 + h] + dtb;
                const float sp = araw > 20.f ? araw : log1pf(__expf(araw));
                sa[tok] = __expf(nAexp * sp); sb[tok] = 1.f / (1.f + __expf(-braw)); sqk[tok] = qk * rq * rk;
            }
        }
        __syncthreads();
        for (int tok = 0; tok < 16; ++tok) {
            f32x4 kk[8], qq[8];
#pragma unroll
            for (int i = 0; i < 8; ++i) { kk[i] = *(const LAS f32x4*)(ks + tok * 128 + kg * 32 + 4 * i); qq[i] = *(const LAS f32x4*)(qs + tok * 128 + kg * 32 + 4 * i); }
            float pk = 0.f, pq = 0.f;
#pragma unroll
            for (int i = 0; i < 8; ++i) {
                pk += kk[i].x * S[4 * i] + kk[i].y * S[4 * i + 1] + kk[i].z * S[4 * i + 2] + kk[i].w * S[4 * i + 3];
                pq += qq[i].x * S[4 * i] + qq[i].y * S[4 * i + 1] + qq[i].z * S[4 * i + 2] + qq[i].w * S[4 * i + 3]; }
            part[(buf * 4 + kg) * 128 + dv] = (f32x2){pk, pq};
            __syncthreads();
            const f32x2 p0 = part[(buf * 4 + 0) * 128 + dv], p1 = part[(buf * 4 + 1) * 128 + dv], p2 = part[(buf * 4 + 2) * 128 + dv], p3 = part[(buf * 4 + 3) * 128 + dv];
            const float kS = (p0.x + p1.x) + (p2.x + p3.x), qS = (p0.y + p1.y) + (p2.y + p3.y);
            const float a = sa[tok], bt = sb[tok], qkv = sqk[tok], vv = vs[tok * 128 + dv];
            const float dlt = bt * (vv - a * kS);
#pragma unroll
            for (int i = 0; i < 8; ++i) {
                S[4 * i] = a * S[4 * i] + kk[i].x * dlt; S[4 * i + 1] = a * S[4 * i + 1] + kk[i].y * dlt; S[4 * i + 2] = a * S[4 * i + 2] + kk[i].z * dlt; S[4 * i + 3] = a * S[4 * i + 3] + kk[i].w * dlt; }
            if (kg == 0) os[tok * 128 + dv] = a * qS + qkv * dlt;
            buf ^= 1;
        }
        __syncthreads();
#pragma unroll
        for (int rr = 0; rr < 2; ++rr) {
            const int tok = wave + 8 * rr; const size_t row = (size_t)(rowbase + t0 + tok);
            const float o0 = os[tok * 128 + lane], o1 = os[tok * 128 + lane + 64];
            const float rstd = rsqrtf(wave_sum(o0 * o0 + o1 * o1) * (1.f / 128.f) + EPS);
            const float g0 = bf2f(proj[row * NPROJ + C_GA + h * 128 + lane]), g1 = bf2f(proj[row * NPROJ + C_GA + h * 128 + lane + 64]);
            mix[row * D + h * 128 + lane] = f2bf(o0 * rstd * gn0 * silu_f(g0));
            mix[row * D + h * 128 + lane + 64] = f2bf(o1 * rstd * gn1 * silu_f(g1));
        }
    }
#pragma unroll
    for (int i = 0; i < 32; ++i) sout[(size_t)(kg * 32 + i) * 128 + dv] = S[i];
    __syncthreads();
}

template <int J, int... II> __device__ __forceinline__ void fs_col_apply(float (&x)[32], const float (&mv)[2], std::integer_sequence<int, II...>) {
    (fmac_bc<(J + 1 + II) & 15>(x[J + 1 + II], mv[(J + 1 + II) >> 4], x[J]), ...);
}
template <int J> __device__ __forceinline__ void fs_col_load(float (&mv)[2], const LAS float* Mb, int l15) {
#pragma unroll
    for (int q = 0; q < 2; ++q) if (16 * q + 15 > J) mv[q] = Mb[(16 * q + l15) * 68 + J];
}
template <int J> __device__ __forceinline__ void fs_col(float (&x)[32], float (&mvc)[2], const LAS float* Mb, int l15) {
    float mvn[2] = {0.f, 0.f};
    if constexpr (J + 1 < 31) fs_col_load<J + 1>(mvn, Mb, l15);
    fs_col_apply<J>(x, mvc, std::make_integer_sequence<int, 31 - J>{});
#pragma unroll
    for (int q = 0; q < 2; ++q) mvc[q] = mvn[q];
}
template <int... JJ> __device__ __forceinline__ void fs_all(float (&x)[32], const LAS float* Mb, int l15, std::integer_sequence<int, JJ...>) {
    float mvc[2] = {0.f, 0.f}; fs_col_load<0>(mvc, Mb, l15); (fs_col<JJ>(x, mvc, Mb, l15), ...);
}
constexpr int CS_Q = 136, CS_VU = 132, CS_M = 68, CS_T = 72;
constexpr int C_M = 0, C_Q = 17408, C_QG = 34816, C_K = 52224, C_KDT = 69632, C_VU = 88064, C_QKM = 121856, C_SC = 131072;
#define LDS_BARRIER() do { asm volatile("s_waitcnt lgkmcnt(0)" ::: "memory"); __builtin_amdgcn_s_barrier(); asm volatile("" ::: "memory"); } while (0)
__device__ __forceinline__ void gdn_chunk_item(const Params& p, LAS unsigned char* L, int b, int h, float* sout, int tid_unused, int wave, int lane_in) {
    int lane = opq(lane_in);
    const bf16_t* proj = (const bf16_t*)(p.ws + WS_PROJ);
    const float* BA = (const float*)(p.ws + WS_BA);
    bf16_t* mix = (bf16_t*)(p.ws + WS_MIX);
    LAS bf16_t* Qb = (LAS bf16_t*)(L + C_Q); LAS bf16_t* QGb = (LAS bf16_t*)(L + C_QG); LAS bf16_t* Kb = (LAS bf16_t*)(L + C_K); LAS bf16_t* KDt = (LAS bf16_t*)(L + C_KDT);
    LAS float* VU = (LAS float*)(L + C_VU); LAS float* Mm = (LAS float*)(L + C_M); LAS bf16_t* QKm = (LAS bf16_t*)(L + C_QKM);
    LAS float* sgc = (LAS float*)(L + C_SC); LAS float* sbeta = sgc + 64; LAS float* sbg = sgc + 128;
    LAS bf16_t* Wb = Qb;
    int fr = lane & 15, g = lane >> 4;
    const size_t rowbase = (size_t)b * TP;
    float cw[4][3][2];
#pragma unroll
    for (int tap = 0; tap < 4; ++tap)
#pragma unroll
        for (int pt = 0; pt < 3; ++pt) { const f32x2 t = *(const f32x2*)(p.in[13] + tap * 1536 + pt * 512 + h * 128 + 2 * lane); cw[tap][pt][0] = t.x; cw[tap][pt][1] = t.y; }
    const float nAexp = -__expf(p.in[14][h]), dtb = p.in[15][h];
    const f32x2 gn = *(const f32x2*)(p.in[16] + 2 * lane);
    f32x4 Sacc[8];
#pragma unroll
    for (int i = 0; i < 8; ++i) Sacc[i] = (f32x4){0.f, 0.f, 0.f, 0.f};
    float pf_b, pf_a; unsigned pf_raw[11][3], pf_gate[8];
#define GDN_PREFETCH(T0) do { const int t0n_ = (T0); \
        { const size_t row_ = rowbase + t0n_ + lane; pf_b = BA[row_ * 8 + h]; pf_a = BA[row_ * 8 + 4 + h]; } \
        _Pragma("unroll") for (int r = 0; r < 11; ++r) { const int tr = t0n_ + 8 * wave - 3 + r; \
            _Pragma("unroll") for (int pt = 0; pt < 3; ++pt) pf_raw[r][pt] = (tr >= 0) ? *(const unsigned*)(proj + (rowbase + tr) * NPROJ + pt * 512 + h * 128 + 2 * lane) : 0u; } \
        _Pragma("unroll") for (int j = 0; j < 8; ++j) pf_gate[j] = *(const unsigned*)(proj + (rowbase + t0n_ + 8 * wave + j) * NPROJ + C_GA + h * 128 + 2 * lane); } while (0)
    GDN_PREFETCH(0);
    for (int c = 0; c < 32; ++c) {
        const int t0 = c * 64;
        lane = opq(lane_in);
        float beta, gcs, gam, kdl, glast, gl0, gl1;
        {
            const float braw = pf_b, araw = pf_a + dtb;
            const float sp = araw > 20.f ? araw : __logf(1.f + __expf(araw));
            gcs = nAexp * sp; beta = sigmoid_f(braw);
            gcs += dpp_f<0x111>(gcs); gcs += dpp_f<0x112>(gcs); gcs += dpp_f<0x114>(gcs); gcs += dpp_f<0x118>(gcs);
            { const float t15 = __int_as_float(__builtin_amdgcn_readlane(__float_as_int(gcs), 15)), t47 = __int_as_float(__builtin_amdgcn_readlane(__float_as_int(gcs), 47));
              if (lane & 16) gcs += (lane < 32) ? t15 : t47; }
            gl0 = __int_as_float(__builtin_amdgcn_readlane(__float_as_int(gcs), 31)); gl1 = __int_as_float(__builtin_amdgcn_readlane(__float_as_int(gcs), 63)); glast = lane < 32 ? gl0 : gl1;
            gam = __expf(gcs); kdl = __expf(glast - gcs);
            if (wave == 0) { sgc[lane] = gcs; sbeta[lane] = beta; sbg[lane] = beta * gam; }
        }
        unsigned gatev[8];
        {
#pragma unroll
            for (int j = 0; j < 8; ++j) gatev[j] = pf_gate[j];
#pragma unroll
            for (int j = 0; j < 8; ++j) {
                const int tok = 8 * wave + j;
                float y[3][2];
#pragma unroll
                for (int pt = 0; pt < 3; ++pt) { float a0 = 0.f, a1 = 0.f;
#pragma unroll
                    for (int tap = 0; tap < 4; ++tap) { const unsigned u = pf_raw[j + tap][pt]; a0 += cw[tap][pt][0] * __uint_as_float(u << 16); a1 += cw[tap][pt][1] * __uint_as_float(u & 0xffff0000u); }
                    y[pt][0] = silu_f(a0); y[pt][1] = silu_f(a1); }
                const float rq = rsqrtf(wave_sum_u(y[0][0] * y[0][0] + y[0][1] * y[0][1]) + EPS) * 0.08838834764831845f;
                const float rk = rsqrtf(wave_sum_u(y[1][0] * y[1][0] + y[1][1] * y[1][1]) + EPS);
                const float gm = __int_as_float(__builtin_amdgcn_readlane(__float_as_int(gam), tok)), bt = __int_as_float(__builtin_amdgcn_readlane(__float_as_int(beta), tok)), kd = __int_as_float(__builtin_amdgcn_readlane(__float_as_int(kdl), tok));
                const float q0 = y[0][0] * rq, q1 = y[0][1] * rq, k0 = y[1][0] * rk, k1 = y[1][1] * rk;
                *(LAS unsigned*)(Qb + tok * CS_Q + 2 * lane) = cvt_pk_bf16(q0, q1);
                *(LAS unsigned*)(QGb + tok * CS_Q + 2 * lane) = cvt_pk_bf16(q0 * gm, q1 * gm);
                *(LAS unsigned*)(Kb + tok * CS_Q + 2 * lane) = cvt_pk_bf16(k0, k1);
                const unsigned kdp = cvt_pk_bf16(k0 * kd, k1 * kd);
                KDt[(2 * lane) * CS_T + tok] = (bf16_t)(kdp & 0xffffu); KDt[(2 * lane + 1) * CS_T + tok] = (bf16_t)(kdp >> 16);
                *(LAS f32x2*)(VU + tok * CS_VU + 2 * lane) = (f32x2){bt * y[2][0], bt * y[2][1]};
            }
            if (c + 1 < 32) GDN_PREFETCH(t0 + 64);
        }
        LDS_BARRIER();
        lane = opq(lane_in); fr = lane & 15; g = lane >> 4; const int tid = wave * 64 + lane;
        { const int hf = tid >> 8, i = (tid >> 4) & 15, j = tid & 15; QKm[(32 * hf + i) * CS_T + 32 * hf + 16 + j] = 0; }
        for (int tix = wave; tix < 12; tix += 8) {
            const int kind = tix >= 6 ? 1 : 0, tl = tix - 6 * kind;
            const int it = tl < 3 ? (tl >= 1 ? 1 : 0) : (tl >= 4 ? 3 : 2), jt = tl < 3 ? (tl == 2 ? 1 : 0) : (tl == 5 ? 3 : 2);
            const LAS bf16_t* As = kind ? Qb : Kb;
            f32x4 acc = (f32x4){0.f, 0.f, 0.f, 0.f};
#pragma unroll
            for (int ks = 0; ks < 4; ++ks) { const bf16x8 a = *(const LAS bf16x8*)(As + (it * 16 + fr) * CS_Q + ks * 32 + g * 8), bb = *(const LAS bf16x8*)(Kb + (jt * 16 + fr) * CS_Q + ks * 32 + g * 8);
                acc = __builtin_amdgcn_mfma_f32_16x16x32_bf16(a, bb, acc, 0, 0, 0); }
            const int j = jt * 16 + fr; const float gcj = sgc[j];
#pragma unroll
            for (int r = 0; r < 4; ++r) { const int i = it * 16 + 4 * g + r; const float dec = __expf(fminf(sgc[i] - gcj, 0.f));
                if (kind == 0) Mm[i * CS_M + j] = (i > j) ? -(acc[r] * dec * sbeta[i]) : 0.f;
                else QKm[i * CS_T + j] = (i >= j) ? f2bf(acc[r] * dec) : (bf16_t)0; }
        }
        LDS_BARRIER();
        {
            float x[32];
            const int l3 = opq(lane_in), sub = wave >> 2, wq = wave & 3, cc = (wq & 1) * 64 + l3, r0 = 32 * sub;
            if (wq < 2) {
#pragma unroll
                for (int i = 0; i < 32; ++i) x[i] = VU[(r0 + i) * CS_VU + cc];
            } else {
#pragma unroll
                for (int i = 0; i < 32; ++i) x[i] = bf2f(Kb[(r0 + i) * CS_Q + cc]) * sbg[r0 + i];
            }
            fs_all(x, Mm + r0 * CS_M + r0, l3 & 15, std::make_integer_sequence<int, 31>{});
            if (wq < 2) {
#pragma unroll
                for (int i = 0; i < 32; ++i) VU[(r0 + i) * CS_VU + cc] = x[i];
            } else {
#pragma unroll
                for (int i = 0; i < 32; ++i) Wb[(r0 + i) * CS_Q + cc] = f2bf(-x[i]);
            }
        }
        LDS_BARRIER();
        lane = opq(lane_in); fr = lane & 15; g = lane >> 4;
#pragma unroll
        for (int sub = 0; sub < 2; ++sub) {
            const float glw = __expf(sub ? gl1 : gl0);
            f32x4 ua[2]; u32x2 wf[2][4][2], qf[2][4][2], mf[2][2], kf[8][2];
#pragma unroll
            for (int t2 = 0; t2 < 2; ++t2) { const int tt = 2 * sub + t2;
#pragma unroll
                for (int r = 0; r < 4; ++r) ua[t2][r] = VU[(tt * 16 + 4 * g + r) * CS_VU + 16 * wave + fr];
#pragma unroll
                for (int ks = 0; ks < 4; ++ks) { const LAS bf16_t* wp = Wb + (tt * 16 + fr) * CS_Q + ks * 32 + 4 * g; const LAS bf16_t* qp = QGb + (tt * 16 + fr) * CS_Q + ks * 32 + 4 * g;
                    wf[t2][ks][0] = *(const LAS u32x2*)wp; wf[t2][ks][1] = *(const LAS u32x2*)(wp + 16); qf[t2][ks][0] = *(const LAS u32x2*)qp; qf[t2][ks][1] = *(const LAS u32x2*)(qp + 16); } }
            asm volatile("s_waitcnt lgkmcnt(0)" ::: "memory");
            bf16x8 Sb[4];
#pragma unroll
            for (int ks = 0; ks < 4; ++ks) { const f32x4 lo = Sacc[2 * ks], hi = Sacc[2 * ks + 1];
                const u32x4 w = (u32x4){cvt_pk_bf16(lo.x, lo.y), cvt_pk_bf16(lo.z, lo.w), cvt_pk_bf16(hi.x, hi.y), cvt_pk_bf16(hi.z, hi.w)}; Sb[ks] = __builtin_bit_cast(bf16x8, w); }
            f32x4 vn[2], oo[2];
#pragma unroll
            for (int t2 = 0; t2 < 2; ++t2) { vn[t2] = ua[t2]; oo[t2] = (f32x4){0.f, 0.f, 0.f, 0.f}; }
#pragma unroll
            for (int ks = 0; ks < 4; ++ks)
#pragma unroll
                for (int t2 = 0; t2 < 2; ++t2) {
                    const u32x4 wa = (u32x4){wf[t2][ks][0].x, wf[t2][ks][0].y, wf[t2][ks][1].x, wf[t2][ks][1].y}, qa = (u32x4){qf[t2][ks][0].x, qf[t2][ks][0].y, qf[t2][ks][1].x, qf[t2][ks][1].y};
                    vn[t2] = __builtin_amdgcn_mfma_f32_16x16x32_bf16(__builtin_bit_cast(bf16x8, wa), Sb[ks], vn[t2], 0, 0, 0);
                    oo[t2] = __builtin_amdgcn_mfma_f32_16x16x32_bf16(__builtin_bit_cast(bf16x8, qa), Sb[ks], oo[t2], 0, 0, 0);
                }
            __builtin_amdgcn_sched_barrier(0);
#pragma unroll
            for (int t2 = 0; t2 < 2; ++t2) { const LAS bf16_t* ap = QKm + ((2 * sub + t2) * 16 + fr) * CS_T + 32 * sub + 4 * g; mf[t2][0] = *(const LAS u32x2*)ap; mf[t2][1] = *(const LAS u32x2*)(ap + 16); }
#pragma unroll
            for (int dkt = 0; dkt < 8; ++dkt) { const LAS bf16_t* ap = KDt + (dkt * 16 + fr) * CS_T + 32 * sub + 4 * g; kf[dkt][0] = *(const LAS u32x2*)ap; kf[dkt][1] = *(const LAS u32x2*)(ap + 16); }
            asm volatile("s_waitcnt lgkmcnt(0)" ::: "memory");
            bf16x8 Vb;
            { const f32x4 lo = vn[0], hi = vn[1];
                const u32x4 w = (u32x4){cvt_pk_bf16(lo.x, lo.y), cvt_pk_bf16(lo.z, lo.w), cvt_pk_bf16(hi.x, hi.y), cvt_pk_bf16(hi.z, hi.w)}; Vb = __builtin_bit_cast(bf16x8, w); }
#pragma unroll
            for (int dkt = 0; dkt < 8; ++dkt) { const u32x4 aa = (u32x4){kf[dkt][0].x, kf[dkt][0].y, kf[dkt][1].x, kf[dkt][1].y};
                Sacc[dkt] = __builtin_amdgcn_mfma_f32_16x16x32_bf16(__builtin_bit_cast(bf16x8, aa), Vb, Sacc[dkt] * glw, 0, 0, 0); }
#pragma unroll
            for (int t2 = 0; t2 < 2; ++t2) { const int tt = 2 * sub + t2;
                const u32x4 aa = (u32x4){mf[t2][0].x, mf[t2][0].y, mf[t2][1].x, mf[t2][1].y};
                const f32x4 o = __builtin_amdgcn_mfma_f32_16x16x32_bf16(__builtin_bit_cast(bf16x8, aa), Vb, oo[t2], 0, 0, 0);
#pragma unroll
                for (int r = 0; r < 4; ++r) VU[(tt * 16 + 4 * g + r) * CS_VU + 16 * wave + fr] = o[r]; }
        }
        LDS_BARRIER();
        lane = opq(lane_in);
#pragma unroll
        for (int j = 0; j < 8; ++j) {
            const int tok = 8 * wave + j;
            const f32x2 o = *(const LAS f32x2*)(VU + tok * CS_VU + 2 * lane);
            const float rstd = rsqrtf(wave_sum_u(o.x * o.x + o.y * o.y) * (1.f / 128.f) + EPS);
            const float g0 = __uint_as_float(gatev[j] << 16), g1 = __uint_as_float(gatev[j] & 0xffff0000u);
            *(unsigned*)(mix + (rowbase + t0 + tok) * D + h * 128 + 2 * lane) = cvt_pk_bf16(o.x * rstd * gn.x * silu_f(g0), o.y * rstd * gn.y * silu_f(g1));
        }
    }
    lane = opq(lane_in); fr = lane & 15; g = lane >> 4;
#pragma unroll
    for (int dkt = 0; dkt < 8; ++dkt)
#pragma unroll
        for (int r = 0; r < 4; ++r) sout[(size_t)(dkt * 16 + 4 * g + r) * 128 + 16 * wave + fr] = Sacc[dkt][r];
#undef GDN_PREFETCH
    __syncthreads();
}

constexpr int A_TB = 132096;
__device__ __forceinline__ void attn_prompt_item(const Params& p, LAS unsigned char* L, int b, int c, int wave, int lane_in) {
    const int lane = opq(lane_in);
    const bf16_t* proj = (const bf16_t*)(p.ws + WS_PROJ);
    const bf16_t* vt = (const bf16_t*)(p.ws + WS_VT);
    bf16_t* mix = (bf16_t*)(p.ws + WS_MIX);
    const int h = wave, fr = lane & 15, g = lane >> 4;
    const LAS float* Tb = (const LAS float*)(L + A_TB) + h * 320;
    const size_t rowq0 = (size_t)b * TP + c * 64;
    bf16x8 Qf[4][2];
#pragma unroll
    for (int qt = 0; qt < 4; ++qt)
#pragma unroll
        for (int ks = 0; ks < 2; ++ks) Qf[qt][ks] = *(const bf16x8*)(proj + (rowq0 + qt * 16 + fr) * NPROJ + C_QB + h * 64 + ks * 32 + g * 8);
    f32x4 O[4][4]; float ls[4];
#pragma unroll
    for (int dt = 0; dt < 4; ++dt)
#pragma unroll
        for (int qt = 0; qt < 4; ++qt) O[dt][qt] = (f32x4){0.f, 0.f, 0.f, 0.f};
#pragma unroll
    for (int qt = 0; qt < 4; ++qt) ls[qt] = 0.f;
    const int jc0 = (c < 8) ? (8 - c) : 0;
    bf16x8 Kn[2][2], Vn[4];
#define ATT_LOAD(JT) do { const int tok0_ = c * 64 - 512 + (JT) * 32; \
        _Pragma("unroll") for (int kt = 0; kt < 2; ++kt) _Pragma("unroll") for (int ks = 0; ks < 2; ++ks) \
            Kn[kt][ks] = *(const bf16x8*)(proj + ((size_t)b * TP + tok0_ + kt * 16 + fr) * NPROJ + C_KB + h * 64 + ks * 32 + g * 8); \
        _Pragma("unroll") for (int dt = 0; dt < 4; ++dt) { const bf16_t* vp = vt + ((size_t)b * 512 + h * 64 + dt * 16 + fr) * 2048 + tok0_ + 4 * g; \
            const u32x2 lo = *(const u32x2*)vp, hi = *(const u32x2*)(vp + 16); const u32x4 w = (u32x4){lo.x, lo.y, hi.x, hi.y}; Vn[dt] = __builtin_bit_cast(bf16x8, w); } } while (0)
    ATT_LOAD(jc0 * 2);
    for (int jt = jc0 * 2; jt < 18; ++jt) {
        const int kj0 = jt * 32;
        bf16x8 Kf[2][2], Vf[4];
#pragma unroll
        for (int kt = 0; kt < 2; ++kt)
#pragma unroll
            for (int ks = 0; ks < 2; ++ks) Kf[kt][ks] = Kn[kt][ks];
#pragma unroll
        for (int dt = 0; dt < 4; ++dt) Vf[dt] = Vn[dt];
        if (jt + 1 < 18) ATT_LOAD(jt + 1);
        f32x4 St[2][4];
#pragma unroll
        for (int kt = 0; kt < 2; ++kt)
#pragma unroll
            for (int qt = 0; qt < 4; ++qt) { St[kt][qt] = (f32x4){0.f, 0.f, 0.f, 0.f};
#pragma unroll
                for (int ks = 0; ks < 2; ++ks) St[kt][qt] = __builtin_amdgcn_mfma_f32_16x16x32_bf16(Kf[kt][ks], Qf[qt][ks], St[kt][qt], 0, 0, 0); }
        bf16x8 Pf[4];
#pragma unroll
        for (int qt = 0; qt < 4; ++qt) {
            float e[8];
            if (jt < 8) {
                const float tb = Tb[319];
#pragma unroll
                for (int kt = 0; kt < 2; ++kt)
#pragma unroll
                    for (int r = 0; r < 4; ++r) { const float x = __builtin_amdgcn_exp2f(St[kt][qt][r] + tb); e[kt * 4 + r] = x; ls[qt] += x; }
            } else {
#pragma unroll
            for (int kt = 0; kt < 2; ++kt)
#pragma unroll
                for (int r = 0; r < 4; ++r) { const int key = kt * 16 + 4 * g + r, qi = qt * 16 + fr; int idx = qi - (kj0 + key) + 575; idx = idx > 319 ? 319 : idx;
                    const float x = __builtin_amdgcn_exp2f(St[kt][qt][r] + Tb[idx]); e[kt * 4 + r] = x; ls[qt] += x; }
            }
            const u32x4 w = (u32x4){cvt_pk_bf16(e[0], e[1]), cvt_pk_bf16(e[2], e[3]), cvt_pk_bf16(e[4], e[5]), cvt_pk_bf16(e[6], e[7])};
            Pf[qt] = __builtin_bit_cast(bf16x8, w);
        }
#pragma unroll
        for (int dt = 0; dt < 4; ++dt)
#pragma unroll
            for (int qt = 0; qt < 4; ++qt) O[dt][qt] = __builtin_amdgcn_mfma_f32_16x16x32_bf16(Vf[dt], Pf[qt], O[dt][qt], 0, 0, 0);
    }
#undef ATT_LOAD
#pragma unroll
    for (int qt = 0; qt < 4; ++qt) {
        float l = ls[qt]; l += __shfl_xor(l, 16); l += __shfl_xor(l, 32); const float inv = 1.f / l;
        bf16_t* o = mix + (rowq0 + qt * 16 + fr) * D + 512 + h * 64 + 4 * g;
#pragma unroll
        for (int dt = 0; dt < 4; ++dt) { const f32x4 v = O[dt][qt] * inv; u32x2 w; w.x = cvt_pk_bf16(v.x, v.y); w.y = cvt_pk_bf16(v.z, v.w); *(u32x2*)(o + dt * 16) = w; }
    }
}

constexpr int SA_Q = 0, SA_SC = 4096, SA_RI = SA_SC + 16 * 528 * 4;
__device__ __forceinline__ void attn_sample_item(const Params& p, LAS unsigned char* L, int sbi, int h, int tid_in, int wave, int lane_in) {
    const int tid = opq(tid_in), lane = tid & 63;
    const bf16_t* proj = (const bf16_t*)(p.ws + WS_PROJ);
    bf16_t* mix = (bf16_t*)(p.ws + WS_MIX);
    const float* ck = p.in[4]; const float* cv = p.in[5]; const float* rb = p.in[19] + h * 320;
    LAS float* qs = (LAS float*)(L + SA_Q); LAS float* sc = (LAS float*)(L + SA_SC); LAS float* ri = (LAS float*)(L + SA_RI);
    const size_t row0 = (size_t)MP + sbi * 16;
    for (int i = tid; i < 1024; i += NTHREADS) qs[i] = bf2f(proj[(row0 + (i >> 6)) * NPROJ + C_QB + h * 64 + (i & 63)]);
    __syncthreads();
#pragma unroll 1
    for (int pass = 0; pass < 2; ++pass) {
        const int j = pass * 512 + tid;
        if (j < 528) {
            float kr[64];
            if (pass == 0) { const float* kp = ck + (((size_t)sbi * 512 + j) * 8 + h) * 64;
#pragma unroll
                for (int d = 0; d < 16; ++d) { const f32x4 t = *(const f32x4*)(kp + 4 * d); kr[4 * d] = t.x; kr[4 * d + 1] = t.y; kr[4 * d + 2] = t.z; kr[4 * d + 3] = t.w; } }
            else { const bf16_t* kp = proj + (row0 + (j - 512)) * NPROJ + C_KB + h * 64;
#pragma unroll
                for (int d = 0; d < 64; ++d) kr[d] = bf2f(kp[d]); }
            for (int qi = 0; qi < 16; ++qi) {
                float s = 0.f;
#pragma unroll
                for (int d = 0; d < 16; ++d) { const f32x4 q = *(const LAS f32x4*)(qs + qi * 64 + 4 * d); s += (q.x * kr[4 * d] + q.y * kr[4 * d + 1]) + (q.z * kr[4 * d + 2] + q.w * kr[4 * d + 3]); }
                int dd = qi + 512 - j; dd = dd > 256 ? 256 : dd;
                sc[qi * 528 + j] = s + rb[dd + 63] * LOG2E;
            }
        }
    }
    __syncthreads();
#pragma unroll
    for (int rr = 0; rr < 2; ++rr) {
        const int qi = 2 * wave + rr; float m = -3.0e38f;
        for (int j = lane; j < 528; j += 64) m = fmaxf(m, sc[qi * 528 + j]);
        m = wave_max(m); float s = 0.f;
        for (int j = lane; j < 528; j += 64) { const float e = __builtin_amdgcn_exp2f(sc[qi * 528 + j] - m); sc[qi * 528 + j] = e; s += e; }
        s = wave_sum(s); if (lane == 0) ri[qi] = 1.f / s;
    }
    __syncthreads();
    {
        const int dv = tid & 63, ig = tid >> 6; float o0 = 0.f, o1 = 0.f;
        const float* vp = cv + ((size_t)sbi * 512 * 8 + h) * 64 + dv;
#pragma unroll 8
        for (int j = 0; j < 512; ++j) { const float v = vp[(size_t)j * 512]; o0 += sc[(2 * ig) * 528 + j] * v; o1 += sc[(2 * ig + 1) * 528 + j] * v; }
#pragma unroll
        for (int j = 0; j < 16; ++j) { const float v = bf2f(proj[(row0 + j) * NPROJ + C_VB + h * 64 + dv]); o0 += sc[(2 * ig) * 528 + 512 + j] * v; o1 += sc[(2 * ig + 1) * 528 + 512 + j] * v; }
        mix[(row0 + 2 * ig) * D + 512 + h * 64 + dv] = f2bf(o0 * ri[2 * ig]);
        mix[(row0 + 2 * ig + 1) * D + 512 + h * 64 + dv] = f2bf(o1 * ri[2 * ig + 1]);
    }
    __syncthreads();
}

constexpr int Q_GDN_P = 128, Q_GDN_S = 64, Q_ATT_S = 128, Q_ATT_P = 1024, Q_TOTAL = Q_GDN_P + Q_GDN_S + Q_ATT_S + Q_ATT_P;
constexpr int L_ITEM = 142336;
__device__ __forceinline__ void phase3(const Params& p, LAS unsigned char* L, int tid_in, int wave, int lane_in) {
    const int tid = opq(tid_in), lane = tid & 63;
    {
        const float* rb = p.in[19] + wave * 320;
        const float qm = wave_max(fabsf(p.in[17][lane])), km = wave_max(fabsf(p.in[18][lane]));
        float bm = -3.0e38f;
        for (int i = lane; i < 320; i += 64) bm = fmaxf(bm, rb[i]);
        bm = wave_max(bm);
        const float bound = 8.f * qm * km + bm;
        LAS float* Tb = (LAS float*)(L + A_TB) + wave * 320;
        for (int i = lane; i < 320; i += 64) Tb[i] = (rb[i] - bound) * LOG2E;
    }
    __syncthreads();
    unsigned* ctr = (unsigned*)(p.ws + WS_CTL);
    volatile LAS int* sitem = (volatile LAS int*)(L + L_ITEM);
    for (;;) {
        if (tid == 0) *sitem = (int)atomicAdd(ctr, 1u);
        __syncthreads();
        int it = *sitem;
        __syncthreads();
        if (it >= Q_TOTAL) break;
        if (it < Q_GDN_P) { const int b = it >> 2, h = it & 3;
            gdn_chunk_item(p, L, b, h, p.out + O_GDN_P + (size_t)it * 16384, tid, wave, lane); continue; }
        it -= Q_GDN_P;
        if (it < Q_GDN_S) { const int b = it >> 2, h = it & 3;
            gdn_item(p, L, MP + b * 16, 16, h, p.in[3] + (size_t)it * 16384, p.in[2] + (size_t)b * 3 * 1536, p.out + O_GDN_S + (size_t)it * 16384, tid, wave, lane); continue; }
        it -= Q_GDN_S;
        if (it < Q_ATT_S) { attn_sample_item(p, L, it >> 3, it & 7, tid, wave, lane); continue; }
        it -= Q_ATT_S;
        attn_prompt_item(p, L, it >> 5, it & 31, wave, lane);
    }
}

#define XB_TMO      128
#define XB_XCNT(j)  (256  + 64 * (j))
#define XB_XSUB(j)  (1280 + 64 * (j))
#define XB_XGEN(j)  (2304 + 64 * (j))
#define XB_TOP      3328
#define XB_TOPGEN   3392
#define XCD_BAR_WORDS 3456
#define XB_SPIN_CAP (1u << 18)

__device__ __forceinline__ unsigned xb_ld(unsigned* p)              { return __hip_atomic_load(p, __ATOMIC_RELAXED, __HIP_MEMORY_SCOPE_AGENT); }
__device__ __forceinline__ unsigned xb_add(unsigned* p, unsigned v) { return __hip_atomic_fetch_add(p, v, __ATOMIC_RELAXED, __HIP_MEMORY_SCOPE_AGENT); }
__device__ __forceinline__ unsigned xb_xcc_id() { return (unsigned)__builtin_amdgcn_s_getreg((3 << 11) | 20) & 0xFu; }
#define XB_SPIN(cond, bar) do { unsigned _sp = 0; while (cond) { __builtin_amdgcn_s_sleep(1); \
    if ((++_sp & 255u) == 0u) { if (xb_ld(&(bar)[XB_TMO])) break; if (_sp > XB_SPIN_CAP) { atomicAdd(&(bar)[XB_TMO], 1u); break; } } } } while (0)

struct XcdBarrier {
    unsigned* bar; unsigned x;
    volatile LAS unsigned* st;
};

__device__ __forceinline__ XcdBarrier xcd_barrier_post(unsigned* bar, volatile LAS unsigned* st) {
    XcdBarrier b; b.bar = bar; b.x = xb_xcc_id(); b.st = st;
    if (threadIdx.x == 0) (void)xb_add(&bar[XB_XCNT(b.x)], 1u);
    return b;
}
__device__ __forceinline__ void xcd_barrier_complete(unsigned* bar, unsigned x, unsigned& nloc, unsigned& nx) {
    const unsigned G = gridDim.x * gridDim.y * gridDim.z;
    unsigned sum, cnt, mine, sp = 0u;
    for (;;) {
        sum = 0u; cnt = 0u; mine = 0u;
#pragma unroll
        for (unsigned j = 0; j < 16; ++j) { const unsigned c = xb_ld(&bar[XB_XCNT(j)]); sum += c; cnt += (c > 0u) ? 1u : 0u; mine = (j == x) ? c : mine; }
        if (sum == G) break;
        __builtin_amdgcn_s_sleep(1);
        if ((++sp & 255u) == 0u) { if (xb_ld(&bar[XB_TMO])) break; if (sp > XB_SPIN_CAP) { atomicAdd(&bar[XB_TMO], 1u); break; } }
    }
    nloc = mine > 0u ? mine : 1u; nx = cnt > 0u ? cnt : 1u;
}

__device__ __forceinline__ void xcd_barrier(const XcdBarrier& b) {
    asm volatile("s_waitcnt vmcnt(0)" ::: "memory");
    __syncthreads();
    if (threadIdx.x == 0) {
        unsigned* bar = b.bar;
        __builtin_amdgcn_s_waitcnt(0);
        unsigned nloc = b.st[0], nx = b.st[1];
        if (nloc == 0u) { xcd_barrier_complete(bar, b.x, nloc, nx); b.st[0] = nloc; b.st[1] = nx; }
        const unsigned old = xb_add(&bar[XB_XSUB(b.x)], 1u);
        const unsigned gen = old / nloc;
        if (old + 1u == (gen + 1u) * nloc) {
            __builtin_amdgcn_fence(__ATOMIC_RELEASE, "agent");
            asm volatile("s_waitcnt vmcnt(0)" ::: "memory");
            const unsigned og = xb_add(&bar[XB_TOP], 1u);
            const unsigned tg = og / nx;
            if (og + 1u == (tg + 1u) * nx) xb_add(&bar[XB_TOPGEN], 1u);
            else XB_SPIN(xb_ld(&bar[XB_TOPGEN]) == tg, bar);
            __builtin_amdgcn_fence(__ATOMIC_ACQUIRE, "agent");
            xb_add(&bar[XB_XGEN(b.x)], 1u);
            asm volatile("s_waitcnt vmcnt(0)" ::: "memory");
        } else {
            XB_SPIN(xb_ld(&bar[XB_XGEN(b.x)]) == gen, bar);
            __builtin_amdgcn_fence(__ATOMIC_ACQUIRE, "agent");
            asm volatile("s_waitcnt vmcnt(0)" ::: "memory");
        }
    }
    __syncthreads();
}

__global__ void __launch_bounds__(NTHREADS, 2) fwd_megakernel(Params p) {
    extern __shared__ __attribute__((aligned(16))) unsigned char lds_raw[];
    LAS unsigned char* L = (LAS unsigned char*)lds_raw;
    cg::grid_group grid = cg::this_grid();
    const int tid = threadIdx.x, lane = tid & 63, wave = __builtin_amdgcn_readfirstlane(tid >> 6);
    const int G = gridDim.x;
    volatile LAS unsigned* xbst = (volatile LAS unsigned*)(L + LDS_XB);
    if (tid < 2) xbst[tid] = 0u;
    __syncthreads();
    const XcdBarrier xbar = xcd_barrier_post((unsigned*)(p.ws + WS_CTL) + CW_BAR, xbst);
    const bf16_t* H = (const bf16_t*)(p.ws + WS_H);
    const float* MOD = (const float*)(p.ws + WS_MOD);

    grid.sync();
    phase0(p, L, tid, wave, lane);
    xcd_barrier(xbar);
    prepass<true>(p, L, tid, wave, lane);
    xcd_barrier(xbar);
    {
        pg8::Gemm g{H, (const bf16_t*)(p.ws + WS_WIN), M, NPROJ, D}; pg8::StaticOrder S; S.init(M, NPROJ, G, (int)blockIdx.x);
        EpiIn E{(bf16_t*)(p.ws + WS_PROJ), (bf16_t*)(p.ws + WS_VT), p.in[17], p.in[18], p.out, L + 131072};
        pg8::gemm_phase<EpiIn, pg8::StaticOrder, true, true>(L, g, S, E);
    }
    xcd_barrier(xbar);
    phase3(p, L, tid, wave, lane);
    xcd_barrier(xbar);
    {
        pg8::Gemm g{(const bf16_t*)(p.ws + WS_MIX), (const bf16_t*)(p.ws + WS_WOUT), M, D, D}; pg8::StaticOrder S; S.init(M, D, G, (int)blockIdx.x);
        EpiRes<false> E{p.in[0], p.in[1], MOD, 2048, p.out + O_Y, (bf16_t*)(p.ws + WS_X1B)};
        pg8::gemm_phase<EpiRes<false>, pg8::StaticOrder, true, true>(L, g, S, E);
    }
    xcd_barrier(xbar);
    prepass<false>(p, L, tid, wave, lane);
    xcd_barrier(xbar);
    {
        pg8::Gemm g{H, (const bf16_t*)(p.ws + WS_WUP), M, DFF, D}; pg8::StaticOrder S; S.init(M, DFF, G, (int)blockIdx.x);
        EpiUp E{(bf16_t*)(p.ws + WS_PROJ)};
        pg8::gemm_phase<EpiUp, pg8::StaticOrder, true, true>(L, g, S, E);
    }
    xcd_barrier(xbar);
    {
        pg8::Gemm g{(const bf16_t*)(p.ws + WS_PROJ), (const bf16_t*)(p.ws + WS_WDN), M, D, DFF}; pg8::SplitTailOrder S; S.init(MP, D, G, (int)blockIdx.x);
        EpiRes<true> E{nullptr, nullptr, MOD, 5120, p.out + O_Y, (bf16_t*)(p.ws + WS_X1B)};
        pg8::gemm_phase<EpiRes<true>, pg8::SplitTailOrder, true, true>(L, g, S, E);
    }
}

extern "C" void kernel_launch(void* const* d_in, const int* in_sizes, int n_in, void* d_out, int out_size, void* d_ws, size_t ws_size, hipStream_t stream) {
    static int grid = 0;
    if (grid == 0) {
        if (n_in != 23 || ws_size < WS_END) { fprintf(stderr, "kernel_launch: unexpected n_in %d / ws_size %zu\n", n_in, ws_size); grid = -1; return; }
        int dev = 0, cus = 0, per_cu = 0;
        hipGetDevice(&dev);
        hipDeviceGetAttribute(&cus, hipDeviceAttributeMultiprocessorCount, dev);
        if (hipFuncSetAttribute((const void*)fwd_megakernel, hipFuncAttributeMaxDynamicSharedMemorySize, LDS_BYTES) != hipSuccess) { fprintf(stderr, "kernel_launch: hipFuncSetAttribute failed\n"); grid = -1; return; }
        if (hipOccupancyMaxActiveBlocksPerMultiprocessor(&per_cu, (const void*)fwd_megakernel, NTHREADS, LDS_BYTES) != hipSuccess || per_cu < 1) { fprintf(stderr, "kernel_launch: occupancy query failed (%d)\n", per_cu); per_cu = 1; (void)hipGetLastError(); }
        grid = cus * per_cu;
    }
    if (grid < 0) return;
    (void)hipMemsetAsync((char*)d_ws + WS_CTL, 0, 65536, stream);
    Params p{};
    for (int i = 0; i < 23; ++i) p.in[i] = (const float*)d_in[i];
    p.out = (float*)d_out; p.ws = (unsigned char*)d_ws;
    void* args[] = {&p};
    hipError_t e = hipLaunchCooperativeKernel((const void*)fwd_megakernel, dim3(grid), dim3(NTHREADS), args, LDS_BYTES, stream);
    if (e != hipSuccess) fprintf(stderr, "kernel_launch: cooperative launch failed: %s (grid %d)\n", hipGetErrorString(e), grid);
}
```

```cpp
#include <hip/hip_runtime.h>
#include <hip/hip_cooperative_groups.h>
#include <cstdio>
#include <cstdint>
#include <utility>
namespace cg = cooperative_groups;
namespace pg8 {
#define PG8_LAS __attribute__((address_space(3)))
typedef unsigned short bf16_t;
typedef short bf16x8 __attribute__((ext_vector_type(8)));
typedef float f32x4 __attribute__((ext_vector_type(4)));
typedef unsigned u32x4 __attribute__((ext_vector_type(4)));
constexpr int BM = 256, BK = 64, HALF = 128, HTB = HALF * BK * 2  , STAGE_BYTES = 8 * HTB, NXCD = 8, WGM = 8;

__host__ __device__ __forceinline__ int lds_byte(int r, int c) { const int st = (r >> 4) * 2 + (c >> 5), rr = r & 15, cc = c & 31, ob = rr * 64 + cc * 2; return st * 1024 + (ob ^ (((ob >> 9) & 1) << 5)); }
__host__ __device__ __forceinline__ void stage_rc(int b, int& R, int& C) { const int st = b / 1024, sb = b % 1024, swz = sb ^ (((sb >> 9) & 1) << 5); R = (st >> 1) * 16 + swz / 64; C = (st & 1) * 32 + (swz % 64) / 2; }
__host__ __device__ __forceinline__ int perm32(int rho) { const int n = rho >> 4, i = rho & 15; return 8 * (i >> 2) + 4 * n + (i & 3); }

struct Unit { int pm, pn, kq; };
struct Gemm { const bf16_t* A; const bf16_t* Bt; int M, N, K; };

struct StaticOrder {
    int nM, nN, nwg, G, c;
    __host__ __device__ void init(int M, int N, int G_, int c_) { nM = M / BM; nN = N / BM; nwg = nM * nN; G = G_; c = c_; }
    __host__ __device__ bool next(int i, Unit& u) const {
        const long L = (long)i * G + c; if (L >= nwg) return false;
        int wgid = (int)L; { const int q = nwg / NXCD, r = nwg % NXCD, xcd = wgid % NXCD, off = wgid / NXCD; wgid = (xcd < r ? xcd * (q + 1) : r * (q + 1) + (xcd - r) * q) + off; }
        const int nig = WGM * nN, gid = wgid / nig, fm = gid * WGM, gsz = (nM - fm) < WGM ? (nM - fm) : WGM;
        u.pm = fm + ((wgid % nig) % gsz); u.pn = (wgid % nig) / gsz; u.kq = -1; return true;
    }
    __device__ __forceinline__ void a_ready(const Unit&) const {}
    __device__ __forceinline__ void done(const Unit&) const {}
};

struct SplitTailOrder {
    StaticOrder base; int nMp, nN;
    __host__ __device__ void init(int Mp, int N, int G_, int c_) { base.init(Mp, N, G_, c_); nMp = Mp / BM; nN = N / BM; }
    __host__ __device__ bool next(int i, Unit& u) const {
        const long L = (long)i * base.G + base.c;
        if (L < base.nwg) return base.next(i, u);
        const int s = (int)(L - base.nwg); if (s >= 4 * nN) return false;
        u.pm = nMp; u.pn = s % nN; u.kq = s / nN; return true;
    }
    __device__ __forceinline__ void a_ready(const Unit&) const {}
    __device__ __forceinline__ void done(const Unit&) const {}
};
template <class Epi, class Sched, bool ALIGN_EPI = false, bool SP2 = false>
__device__ __forceinline__ void gemm_phase(PG8_LAS unsigned char* lds, const Gemm g, const Sched& S, const Epi& E) {
    int tid_ = threadIdx.x; asm volatile("" : "+v"(tid_));
    const int tid = tid_, wid = __builtin_amdgcn_readfirstlane(tid >> 6), lane = tid & 63, wr = wid >> 2, wc = wid & 3, fr = lane & 15, fq = lane >> 4;
    const int K = g.K, nt = K / BK;
    unsigned voffA[2], voffB[2];
#pragma unroll
    for (int i = 0; i < 2; ++i) { int R, C; stage_rc(tid * 16 + i * 8192, R, C); const int Rb = Epi::PERM ? ((R & ~31) + perm32(R & 31)) : R;
        voffA[i] = (unsigned)(R * K + C) * 2u; voffB[i] = (unsigned)(Rb * K + C) * 2u; }
    const size_t kstep = (size_t)(BK * 2);
    const size_t hstep = (size_t)HALF * K * 2;
    const size_t tstep = 2 * hstep;
    const unsigned ldsw = (unsigned)wid * 1024u;
    const int aoff = lds_byte(wr * 64 + fr, fq * 8), boff = lds_byte(wc * 32 + fr, fq * 8);
#define PG8_SA(b, h) (((b) * 2 + (h)) * HTB)
#define PG8_SB(b, h) ((4 + (b) * 2 + (h)) * HTB)
#define PG8_STAGE(bufoff, gbase, voff) do { _Pragma("unroll") for (int _i = 0; _i < 2; ++_i) \
        __builtin_amdgcn_global_load_lds((const unsigned*)((const char*)(gbase) + (voff)[_i]), (PG8_LAS unsigned*)(lds + (bufoff) + ldsw + _i * 8192), 16, 0, 0); } while (0)
#define PG8_LDA(dst, b, h) do { _Pragma("unroll") for (int m = 0; m < 4; ++m) _Pragma("unroll") for (int k = 0; k < 2; ++k) dst[m][k] = *(const PG8_LAS bf16x8*)(lds + PG8_SA(b, h) + aoff + m * 2048 + k * 1024); } while (0)
#define PG8_LDB(dst, b, h) do { _Pragma("unroll") for (int n = 0; n < 2; ++n) _Pragma("unroll") for (int k = 0; k < 2; ++k) dst[n][k] = *(const PG8_LAS bf16x8*)(lds + PG8_SB(b, h) + boff + n * 2048 + k * 1024); } while (0)
#define PG8_MMA(ai, bj, At, Bt) do { __builtin_amdgcn_s_setprio(1); _Pragma("unroll") for (int m = 0; m < 4; ++m) _Pragma("unroll") for (int n = 0; n < 2; ++n) _Pragma("unroll") for (int k = 0; k < 2; ++k) \
        acc[ai][bj][m][n] = __builtin_amdgcn_mfma_f32_16x16x32_bf16(Bt[n][k], At[m][k], acc[ai][bj][m][n], 0, 0, 0); __builtin_amdgcn_s_setprio(0); } while (0)
#define PG8_WAIT_V(n) asm volatile("s_waitcnt vmcnt(" #n ")" ::: "memory")
#define PG8_WAIT_L(n) asm volatile("s_waitcnt lgkmcnt(" #n ")" ::: "memory")
#define PG8_BAR __builtin_amdgcn_s_barrier()
#define PG8_SCHED __builtin_amdgcn_sched_barrier(0)
    Unit cur, nxt; int ui = 0;
    if (!S.next(0, cur)) return;
    f32x4 acc[2][2][4][2];
#pragma unroll
    for (int a = 0; a < 2; ++a)
#pragma unroll
        for (int b = 0; b < 2; ++b)
#pragma unroll
            for (int m = 0; m < 4; ++m)
#pragma unroll
                for (int n = 0; n < 2; ++n) acc[a][b][m][n] = (f32x4){0.f, 0.f, 0.f, 0.f};
    bf16x8 At[4][2], B0[2][2], B1[2][2];
    const size_t qstep = (size_t)(K / 4) * 2;
    const char* cA = (const char*)g.A + (size_t)cur.pm * tstep + (cur.kq > 0 ? cur.kq * qstep : 0); const char* cB = (const char*)g.Bt + (size_t)cur.pn * tstep + (cur.kq > 0 ? cur.kq * qstep : 0);
    int cnt = cur.kq < 0 ? nt : nt / 4;
    S.a_ready(cur);
    if constexpr (SP2) {
        PG8_STAGE(PG8_SB(0, 0), cB, voffB); PG8_STAGE(PG8_SB(0, 1), cB + hstep, voffB); PG8_STAGE(PG8_SA(0, 0), cA, voffA); PG8_STAGE(PG8_SA(0, 1), cA + hstep, voffA);
        if (wr == 1) PG8_BAR;
        PG8_WAIT_V(2); PG8_BAR;
        PG8_STAGE(PG8_SB(1, 0), cB + kstep, voffB); PG8_STAGE(PG8_SA(1, 0), cA + kstep, voffA); PG8_STAGE(PG8_SB(1, 1), cB + hstep + kstep, voffB);
        PG8_WAIT_V(6); PG8_BAR;
    } else {
        PG8_STAGE(PG8_SB(0, 0), cB, voffB); PG8_STAGE(PG8_SA(0, 0), cA, voffA); PG8_STAGE(PG8_SB(0, 1), cB + hstep, voffB); PG8_STAGE(PG8_SA(0, 1), cA + hstep, voffA);
        if (wr == 1) PG8_BAR;
        PG8_WAIT_V(4); PG8_BAR;
        PG8_STAGE(PG8_SB(1, 0), cB + kstep, voffB); PG8_STAGE(PG8_SA(1, 0), cA + kstep, voffA); PG8_STAGE(PG8_SB(1, 1), cB + hstep + kstep, voffB);
        PG8_WAIT_V(6); PG8_BAR;
    }
    for (;;) {
        const bool has_next = S.next(ui + 1, nxt);
        const size_t nq = (has_next && nxt.kq > 0) ? nxt.kq * qstep : 0;
        const char* nA = has_next ? (const char*)g.A + (size_t)nxt.pm * tstep + nq : cA; const char* nB = has_next ? (const char*)g.Bt + (size_t)nxt.pn * tstep + nq : cB;
        for (int t = 0; t < cnt; t += 2) {
            const bool last = (t == cnt - 2);
            const char* a1 = cA + (size_t)(t + 1) * kstep;
            const char* a2 = last ? nA : cA + (size_t)(t + 2) * kstep; const char* b2 = last ? nB : cB + (size_t)(t + 2) * kstep;
            const char* a3 = a2 + kstep; const char* b3 = b2 + kstep;
            if (last && has_next) S.a_ready(nxt);
            if constexpr (SP2) {
            PG8_LDB(B0, 0, 0); PG8_LDB(B1, 0, 1); PG8_SCHED; PG8_LDA(At, 0, 0); PG8_STAGE(PG8_SA(1, 1), a1 + hstep, voffA);
            PG8_WAIT_V(8); PG8_WAIT_L(0); PG8_BAR; PG8_MMA(0, 0, At, B0); PG8_MMA(0, 1, At, B1); PG8_BAR; PG8_SCHED;
            PG8_LDA(At, 0, 1); PG8_STAGE(PG8_SB(0, 0), b2, voffB); PG8_STAGE(PG8_SB(0, 1), b2 + hstep, voffB); PG8_STAGE(PG8_SA(0, 0), a2, voffA);
            PG8_WAIT_V(8); PG8_WAIT_L(0); PG8_BAR; PG8_MMA(1, 0, At, B0); PG8_MMA(1, 1, At, B1); PG8_BAR; PG8_SCHED;
            PG8_LDB(B0, 1, 0); PG8_LDB(B1, 1, 1); PG8_SCHED; PG8_LDA(At, 1, 0); PG8_STAGE(PG8_SA(0, 1), a2 + hstep, voffA);
            PG8_WAIT_V(8); PG8_WAIT_L(0); PG8_BAR; PG8_MMA(0, 0, At, B0); PG8_MMA(0, 1, At, B1); PG8_BAR; PG8_SCHED;
            PG8_LDA(At, 1, 1); PG8_STAGE(PG8_SB(1, 0), b3, voffB); PG8_STAGE(PG8_SB(1, 1), b3 + hstep, voffB); PG8_STAGE(PG8_SA(1, 0), a3, voffA);
            PG8_WAIT_V(8); PG8_WAIT_L(0); PG8_BAR; PG8_MMA(1, 0, At, B0); PG8_MMA(1, 1, At, B1); PG8_BAR; PG8_SCHED;
            } else {
            PG8_LDB(B0, 0, 0); PG8_SCHED; PG8_LDA(At, 0, 0); PG8_STAGE(PG8_SA(1, 1), a1 + hstep, voffA);
            PG8_WAIT_L(8); PG8_BAR; PG8_WAIT_L(0); PG8_MMA(0, 0, At, B0); PG8_BAR; PG8_SCHED;
            PG8_LDB(B1, 0, 1); PG8_STAGE(PG8_SB(0, 0), b2, voffB);
            PG8_BAR; PG8_WAIT_L(0); PG8_MMA(0, 1, At, B1); PG8_BAR;
            PG8_LDA(At, 0, 1); PG8_STAGE(PG8_SA(0, 0), a2, voffA);
            PG8_BAR; PG8_WAIT_L(0); PG8_MMA(1, 0, At, B0); PG8_BAR; PG8_SCHED;
            PG8_STAGE(PG8_SB(0, 1), b2 + hstep, voffB);
            PG8_WAIT_V(6); PG8_BAR; PG8_MMA(1, 1, At, B1); PG8_BAR;
            PG8_LDB(B0, 1, 0); PG8_SCHED; PG8_LDA(At, 1, 0); PG8_STAGE(PG8_SA(0, 1), a2 + hstep, voffA);
            PG8_WAIT_L(8); PG8_BAR; PG8_WAIT_L(0); PG8_MMA(0, 0, At, B0); PG8_BAR; PG8_SCHED;
            PG8_LDB(B1, 1, 1); PG8_STAGE(PG8_SB(1, 0), b3, voffB);
            PG8_BAR; PG8_WAIT_L(0); PG8_MMA(0, 1, At, B1); PG8_BAR;
            PG8_LDA(At, 1, 1); PG8_STAGE(PG8_SA(1, 0), a3, voffA);
            PG8_BAR; PG8_WAIT_L(0); PG8_MMA(1, 0, At, B0); PG8_BAR; PG8_SCHED;
            PG8_STAGE(PG8_SB(1, 1), b3 + hstep, voffB);
            PG8_WAIT_V(6); PG8_BAR; PG8_MMA(1, 1, At, B1); PG8_BAR;
            }
        }
        if constexpr (ALIGN_EPI) { if (wr == 0) PG8_BAR; }
        if constexpr (!Epi::AFTER_DRAIN) { E(acc, cur, wr, wc, fr, fq); S.done(cur); }
        if (!has_next) break;
#pragma unroll
        for (int a = 0; a < 2; ++a)
#pragma unroll
            for (int b = 0; b < 2; ++b)
#pragma unroll
                for (int m = 0; m < 4; ++m)
#pragma unroll
                    for (int n = 0; n < 2; ++n) acc[a][b][m][n] = (f32x4){0.f, 0.f, 0.f, 0.f};
        cur = nxt; cA = nA; cB = nB; ++ui; cnt = cur.kq < 0 ? nt : nt / 4;
        if constexpr (ALIGN_EPI) { if (wr == 1) PG8_BAR; }
    }
    PG8_WAIT_V(0);
    if constexpr (!ALIGN_EPI) { if (wr == 0) PG8_BAR; }
    PG8_BAR;
    if constexpr (Epi::AFTER_DRAIN) { E.fused(acc, cur, wr, wc, fr, fq, lds, wid, lane); S.done(cur); }
#undef PG8_SA
#undef PG8_SB
#undef PG8_STAGE
#undef PG8_LDA
#undef PG8_LDB
#undef PG8_MMA
#undef PG8_WAIT_V
#undef PG8_WAIT_L
#undef PG8_BAR
#undef PG8_SCHED
}
}

#define LAS __attribute__((address_space(3)))
typedef unsigned short bf16_t;
typedef float f32x4 __attribute__((ext_vector_type(4)));
typedef float f32x2 __attribute__((ext_vector_type(2)));
typedef short bf16x8 __attribute__((ext_vector_type(8)));
typedef unsigned u32x4 __attribute__((ext_vector_type(4)));
typedef unsigned u32x2 __attribute__((ext_vector_type(2)));

constexpr int NTHREADS = 512;
constexpr int D = 1024, TP = 2048, MP = 65536, MS = 256, M = MP + MS, NPROJ = 3584, DFF = 4096, WIN_LD = 3592;
constexpr float EPS = 1e-6f, LOG2E = 1.4426950408889634f;
constexpr int C_QA = 0, C_KA = 512, C_VA = 1024, C_GA = 1536, C_QB = 2048, C_KB = 2560, C_VB = 3072;
constexpr size_t O_Y = 0, O_CONV_P = 67371008, O_GDN_P = 67518464, O_KB_P = 69615616, O_VB_P = 78004224,
                 O_CONV_S = 86392832, O_GDN_S = 86466560, O_KN_S = 87515136, O_VN_S = 87646208;
constexpr size_t MiB = 1u << 20;
constexpr size_t WS_CTL = 0, WS_WIN = 1 * MiB, WS_WOUT = 8 * MiB, WS_WUP = 10 * MiB, WS_WDN = 18 * MiB, WS_MOD = 26 * MiB, WS_BA = 28 * MiB,
                 WS_H = 32 * MiB, WS_MIX = 161 * MiB, WS_VT = 290 * MiB, WS_PROJ = 354 * MiB  , WS_X1B = 880 * MiB  , WS_END = 1010 * MiB;
constexpr int LDS_XB = 147456;
constexpr int LDS_BYTES = 147456 + 256;
constexpr int CW_BAR = 4096;

struct Params { const float* in[23]; float* out; unsigned char* ws; };

__device__ __forceinline__ unsigned cvt_pk_bf16(float lo, float hi) { unsigned r; asm volatile("v_cvt_pk_bf16_f32 %0, %1, %2" : "=v"(r) : "v"(lo), "v"(hi)); return r; }
__device__ __forceinline__ bf16_t f2bf(float f) { return (bf16_t)(cvt_pk_bf16(f, 0.f) & 0xffffu); }
__device__ __forceinline__ float bf2f(bf16_t h) { return __uint_as_float(((unsigned)h) << 16); }
__device__ __forceinline__ float wave_sum(float v) {
#pragma unroll
    for (int o = 1; o < 64; o <<= 1) v += __shfl_xor(v, o);
    return v;
}
__device__ __forceinline__ float wave_max(float v) {
#pragma unroll
    for (int o = 1; o < 64; o <<= 1) v = fmaxf(v, __shfl_xor(v, o));
    return v;
}
template <int CTRL> __device__ __forceinline__ float dpp_f(float v) { return __int_as_float(__builtin_amdgcn_update_dpp(0, __float_as_int(v), CTRL, 0xf, 0xf, true)); }
__device__ __forceinline__ float wave_sum_u(float v) {
    v += dpp_f<0x111>(v); v += dpp_f<0x112>(v); v += dpp_f<0x114>(v); v += dpp_f<0x118>(v);
    const int iv = __float_as_int(v);
    return (__int_as_float(__builtin_amdgcn_readlane(iv, 15)) + __int_as_float(__builtin_amdgcn_readlane(iv, 31))) + (__int_as_float(__builtin_amdgcn_readlane(iv, 47)) + __int_as_float(__builtin_amdgcn_readlane(iv, 63)));
}
template <int N> __device__ __forceinline__ void fmac_bc(float& s, float mv, float xj) { asm("v_fmac_f32_dpp %0, %1, %2 row_newbcast:%3 row_mask:0xf bank_mask:0xf bound_ctrl:1" : "+v"(s) : "v"(mv), "v"(xj), "n"(N)); }
__device__ __forceinline__ int opq(int v) { asm volatile("" : "+v"(v)); return v; }
__device__ __forceinline__ int row_batch(int row) { return row < MP ? (row >> 11) : 32 + ((row - MP) >> 4); }
__device__ __forceinline__ float silu_f(float x) { return x * __builtin_amdgcn_rcpf(1.f + __builtin_amdgcn_exp2f(-LOG2E * x)); }
__device__ __forceinline__ float sigmoid_f(float x) { return __builtin_amdgcn_rcpf(1.f + __builtin_amdgcn_exp2f(-LOG2E * x)); }
__device__ __forceinline__ int perm_pos(int c) { return ((c >> 5) & 1) * 128 + (c >> 6) * 32 + ((c >> 2) & 1) * 16 + ((c >> 3) & 3) * 4 + (c & 3); }

__device__ __forceinline__ void transpose_item(const float* W, int ldw, int K, int N, bool skip8, bf16_t* WT, LAS float* scr, int item, int lane) {
    const int nblk = N / 64, kb = item / nblk, nb = item % nblk, k0 = 64 * kb, n0 = 64 * nb;
    const int soff = (skip8 && n0 >= 2048) ? 8 : 0;
#pragma unroll 8
    for (int i = 0; i < 64; ++i) scr[i * 65 + lane] = W[(size_t)(k0 + i) * ldw + soff + n0 + lane];
    asm volatile("s_waitcnt lgkmcnt(0)" ::: "memory");
    const int c = lane & 7;
#pragma unroll
    for (int j = 0; j < 8; ++j) { const int n = (lane >> 3) + 8 * j; const LAS float* s = scr + (8 * c) * 65 + n;
        u32x4 o; o.x = cvt_pk_bf16(s[0 * 65], s[1 * 65]); o.y = cvt_pk_bf16(s[2 * 65], s[3 * 65]); o.z = cvt_pk_bf16(s[4 * 65], s[5 * 65]); o.w = cvt_pk_bf16(s[6 * 65], s[7 * 65]);
        const int col = n0 + n, drow = (col & ~255) + perm_pos(col & 255);
        *(u32x4*)(WT + (size_t)drow * K + k0 + 8 * c) = o; }
    asm volatile("s_waitcnt lgkmcnt(0)" ::: "memory");
}

template <int... E> __device__ __forceinline__ void mod_fma16(float& acc, float scv, const float (&w)[16], std::integer_sequence<int, E...>) { (fmac_bc<E>(acc, scv, w[E]), ...); }
__device__ __forceinline__ void mod_item(const Params& p, LAS unsigned char* L, int jb, int tid) {
    LAS float* sc = (LAS float*)L;
    LAS float* red = (LAS float*)L;
    const int jj = tid & 31, kg = tid >> 5, j0 = jb * 32;
    const float* cp = p.in[6]; const float* cs = p.in[7]; const float* wm = p.in[8]; const float* bm = p.in[9];
    float* MOD = (float*)(p.ws + WS_MOD);
    float acc[48];
#pragma unroll
    for (int b = 0; b < 48; ++b) acc[b] = 0.f;
    for (int kc = 0; kc < 4; ++kc) {
        __syncthreads();
        for (int i = tid; i < 48 * 256; i += NTHREADS) { const int b = i >> 8, kk = i & 255; const float c = (b < 32) ? cp[b * 1024 + kc * 256 + kk] : cs[(b - 32) * 1024 + kc * 256 + kk]; sc[i] = silu_f(c); }
        __syncthreads();
        {
            float w[16];
#pragma unroll
            for (int e = 0; e < 16; ++e) w[e] = wm[(size_t)(kc * 256 + 16 * kg + e) * 6144 + j0 + jj];
#pragma unroll
            for (int b = 0; b < 48; ++b) { const float scv = sc[b * 256 + 16 * kg + (tid & 15)]; mod_fma16(acc[b], scv, w, std::make_integer_sequence<int, 16>{}); }
        }
    }
    __syncthreads();
#pragma unroll
    for (int b = 0; b < 48; ++b) red[(kg * 48 + b) * 32 + jj] = acc[b];
    __syncthreads();
    for (int i = tid; i < 48 * 32; i += NTHREADS) { const int b = i >> 5, j = i & 31; float s = 0.f;
#pragma unroll
        for (int k = 0; k < 16; ++k) s += red[(k * 48 + b) * 32 + j];
        MOD[b * 6144 + j0 + j] = s + bm[j0 + j]; }
    __syncthreads();
}

__device__ __forceinline__ void phase0(const Params& p, LAS unsigned char* L, int tid, int wave, int lane) {
    constexpr int I_IN = 16 * 56, I_OUT = 16 * 16, I_UP = 16 * 64, I_DN = 64 * 16, NIT = I_IN + I_OUT + I_UP + I_DN, NGRP = NIT / 8, NMOD = 192;
    unsigned* ctr = (unsigned*)(p.ws + WS_CTL) + 1;
    volatile LAS int* sitem = (volatile LAS int*)(L + 142336);
    LAS float* scr = (LAS float*)(L + wave * 16640);
    for (;;) {
        if (tid == 0) *sitem = (int)atomicAdd(ctr, 1u);
        __syncthreads();
        const int it = *sitem;
        __syncthreads();
        if (it >= NMOD + NGRP) break;
        if (it < NMOD) { mod_item(p, L, it, tid); continue; }
        int r = (it - NMOD) * 8 + wave;
        if (r < I_IN) { transpose_item(p.in[12], WIN_LD, D, NPROJ, true, (bf16_t*)(p.ws + WS_WIN), scr, r, lane); continue; } r -= I_IN;
        if (r < I_OUT) { transpose_item(p.in[20], D, D, D, false, (bf16_t*)(p.ws + WS_WOUT), scr, r, lane); continue; } r -= I_OUT;
        if (r < I_UP) { transpose_item(p.in[21], DFF, D, DFF, false, (bf16_t*)(p.ws + WS_WUP), scr, r, lane); continue; } r -= I_UP;
        transpose_item(p.in[22], D, DFF, D, false, (bf16_t*)(p.ws + WS_WDN), scr, r, lane);
    }
}

#define PP_EO(j) (8 * lane + 512 * ((j) >> 1) + 4 * ((j) & 1))
template <bool FIRST>
__device__ __forceinline__ void prepass(const Params& p, LAS unsigned char* L, int tid, int wave, int lane) {
    const float* MOD = (const float*)(p.ws + WS_MOD);
    bf16_t* H = (bf16_t*)(p.ws + WS_H);
    float* BA = (float*)(p.ws + WS_BA);
    LAS float* wba = (LAS float*)L;
    if (FIRST) {
        const float* win = p.in[12];
        for (int i = tid; i < 8192; i += NTHREADS) { const int k = i >> 3, c = i & 7; wba[c * 1024 + k] = win[(size_t)k * WIN_LD + 2048 + c]; }
        __syncthreads();
    }
    const float* gn = FIRST ? p.in[10] : p.in[11];
    const int shoff = FIRST ? 0 : 3072, scoff = FIRST ? 1024 : 4096;
    f32x4 g[4];
#pragma unroll
    for (int j = 0; j < 4; ++j) g[j] = *(const f32x4*)(gn + PP_EO(j));
    const int gw = blockIdx.x * 8 + wave, NGW = gridDim.x * 8;
    const bf16_t* X1B = (const bf16_t*)(p.ws + WS_X1B);
    auto ldrow = [&](int row, f32x4 (&dst)[4]) {
#pragma unroll
        for (int gr = 0; gr < 2; ++gr) {
            if (FIRST) { const float* xr = (row < MP ? p.in[0] + (size_t)row * D : p.in[1] + (size_t)(row - MP) * D) + 8 * lane + 512 * gr; dst[2 * gr] = *(const f32x4*)xr; dst[2 * gr + 1] = *(const f32x4*)(xr + 4); }
            else { const u32x4 w = *(const u32x4*)(X1B + (size_t)row * D + 8 * lane + 512 * gr);
                dst[2 * gr] = (f32x4){__uint_as_float(w.x << 16), __uint_as_float(w.x & 0xffff0000u), __uint_as_float(w.y << 16), __uint_as_float(w.y & 0xffff0000u)};
                dst[2 * gr + 1] = (f32x4){__uint_as_float(w.z << 16), __uint_as_float(w.z & 0xffff0000u), __uint_as_float(w.w << 16), __uint_as_float(w.w & 0xffff0000u)}; }
        } };
    f32x4 vn[4];
    if (gw < M) ldrow(gw, vn);
    for (int row = gw; row < M; row += NGW) {
        const int b = row_batch(row);
        f32x4 v[4]; float ss = 0.f;
#pragma unroll
        for (int j = 0; j < 4; ++j) { v[j] = vn[j]; ss += (v[j].x * v[j].x + v[j].y * v[j].y) + (v[j].z * v[j].z + v[j].w * v[j].w); }
        if (row + NGW < M) ldrow(row + NGW, vn);
        const float rstd = rsqrtf(wave_sum_u(ss) * (1.f / D) + EPS);
        const float* mb = MOD + (size_t)b * 6144;
#pragma unroll
        for (int j = 0; j < 4; ++j) { const f32x4 sc = *(const f32x4*)(mb + scoff + PP_EO(j)), sh = *(const f32x4*)(mb + shoff + PP_EO(j));
            v[j] = v[j] * rstd * g[j] * (sc + 1.f) + sh; }
#pragma unroll
        for (int gr = 0; gr < 2; ++gr) { u32x4 w; w.x = cvt_pk_bf16(v[2 * gr].x, v[2 * gr].y); w.y = cvt_pk_bf16(v[2 * gr].z, v[2 * gr].w); w.z = cvt_pk_bf16(v[2 * gr + 1].x, v[2 * gr + 1].y); w.w = cvt_pk_bf16(v[2 * gr + 1].z, v[2 * gr + 1].w);
            *(u32x4*)(H + (size_t)row * D + 8 * lane + 512 * gr) = w; }
        if (FIRST) {
            float mine = 0.f;
#pragma unroll
            for (int c = 0; c < 8; ++c) { float s = 0.f;
#pragma unroll
                for (int j = 0; j < 4; ++j) { const f32x4 w = *(const LAS f32x4*)(wba + c * 1024 + PP_EO(j)); s += (v[j].x * w.x + v[j].y * w.y) + (v[j].z * w.z + v[j].w * w.w); }
                s = wave_sum_u(s); if (lane == c) mine = s; }
            if (lane < 8) BA[(size_t)row * 8 + lane] = mine;
        }
    }
}

#undef PP_EO
struct EpiIn {
    static constexpr bool PERM = false, AFTER_DRAIN = false;
    bf16_t* proj; bf16_t* vt; const float* qn_g; const float* kn_g; float* out; LAS unsigned char* xl;
    __device__ __forceinline__ void operator()(const f32x4 (&acc)[2][2][4][2], const pg8::Unit& u, int wr, int wc, int fr, int fq) const {
        const int grp = u.pn >> 1;
        const int col0 = u.pn * 256 + wc * 64 + fq * 8;
        const bool samp = (u.pm == 256);
        const bool nrm = (grp == 4 || grp == 5);
        f32x4 gq[2][2];
        if (nrm) { const float* gp = (grp == 4) ? qn_g : kn_g; const float scl = (grp == 4) ? 0.125f * LOG2E : 1.f;
#pragma unroll
            for (int bj = 0; bj < 2; ++bj)
#pragma unroll
                for (int n = 0; n < 2; ++n) gq[bj][n] = *(const f32x4*)(gp + bj * 32 + fq * 8 + n * 4) * scl; }
#pragma unroll
        for (int ai = 0; ai < 2; ++ai)
#pragma unroll
            for (int m = 0; m < 4; ++m) {
                const int row = u.pm * 256 + ai * 128 + wr * 64 + m * 16 + fr;
                f32x4 v[2][2];
#pragma unroll
                for (int bj = 0; bj < 2; ++bj)
#pragma unroll
                    for (int n = 0; n < 2; ++n) v[bj][n] = acc[ai][bj][m][n];
                if (nrm) {
                    float ss = 0.f;
#pragma unroll
                    for (int bj = 0; bj < 2; ++bj)
#pragma unroll
                        for (int n = 0; n < 2; ++n) ss += (v[bj][n].x * v[bj][n].x + v[bj][n].y * v[bj][n].y) + (v[bj][n].z * v[bj][n].z + v[bj][n].w * v[bj][n].w);
                    ss += __shfl_xor(ss, 16); ss += __shfl_xor(ss, 32);
                    const float rstd = rsqrtf(ss * (1.f / 64.f) + EPS);
#pragma unroll
                    for (int bj = 0; bj < 2; ++bj)
#pragma unroll
                        for (int n = 0; n < 2; ++n) v[bj][n] = v[bj][n] * rstd * gq[bj][n];
                }
                bf16_t* pr = proj + (size_t)row * NPROJ + col0;
#pragma unroll
                for (int bj = 0; bj < 2; ++bj) { u32x4 w; w.x = cvt_pk_bf16(v[bj][0].x, v[bj][0].y); w.y = cvt_pk_bf16(v[bj][0].z, v[bj][0].w); w.z = cvt_pk_bf16(v[bj][1].x, v[bj][1].y); w.w = cvt_pk_bf16(v[bj][1].z, v[bj][1].w);
                    *(u32x4*)(pr + bj * 32) = w; }
                int b, t; if (!samp) { b = row >> 11; t = row & 2047; } else { b = (row - MP) >> 4; t = (row - MP) & 15; }
                if (grp <= 2) {
                    const int tl = samp ? t - 13 : t - 2045;
                    if (tl >= 0) { float* o = out + (samp ? O_CONV_S : O_CONV_P) + ((size_t)b * 3 + tl) * 1536 + col0;
#pragma unroll
                        for (int bj = 0; bj < 2; ++bj)
#pragma unroll
                            for (int n = 0; n < 2; ++n) *(f32x4*)(o + bj * 32 + n * 4) = v[bj][n]; }
                } else if (grp >= 5) {
                    const int cc = col0 - (grp == 5 ? C_KB : C_VB);
                    if (!samp) {
                        if (t >= 1536) { float* o = out + (grp == 5 ? O_KB_P : O_VB_P) + ((size_t)b * 512 + (t - 1536)) * 512 + cc;
#pragma unroll
                            for (int bj = 0; bj < 2; ++bj)
#pragma unroll
                                for (int n = 0; n < 2; ++n) *(f32x4*)(o + bj * 32 + n * 4) = v[bj][n]; }
                        if (grp == 6) {
                            LAS bf16_t* tb = (LAS bf16_t*)(xl + (wr * 4 + wc) * 2048);
#pragma unroll
                            for (int bj = 0; bj < 2; ++bj)
#pragma unroll
                                for (int n = 0; n < 2; ++n)
#pragma unroll
                                    for (int j = 0; j < 4; ++j) tb[(bj * 32 + fq * 8 + n * 4 + j) * 16 + fr] = f2bf(v[bj][n][j]);
                            asm volatile("s_waitcnt lgkmcnt(0)" ::: "memory");
                            const int ln = fq * 16 + fr;
                            const u32x4 lo = *(const LAS u32x4*)(tb + ln * 16), hi = *(const LAS u32x4*)(tb + ln * 16 + 8);
                            bf16_t* vp = vt + ((size_t)b * 512 + (cc - fq * 8) + ln) * 2048 + (t - fr);
                            *(u32x4*)vp = lo; *(u32x4*)(vp + 8) = hi;
                            asm volatile("s_waitcnt lgkmcnt(0)" ::: "memory");
                        }
                    } else { float* o = out + (grp == 5 ? O_KN_S : O_VN_S) + ((size_t)b * 16 + t) * 512 + cc;
#pragma unroll
                        for (int bj = 0; bj < 2; ++bj)
#pragma unroll
                            for (int n = 0; n < 2; ++n) *(f32x4*)(o + bj * 32 + n * 4) = v[bj][n]; }
                }
            }
    }
};
template <bool INPLACE>
struct EpiRes {
    static constexpr bool PERM = false, AFTER_DRAIN = false;
    const float* xp; const float* xs; const float* mod; int goff; float* out; bf16_t* x1b;
    __device__ __forceinline__ void operator()(const f32x4 (&acc)[2][2][4][2], const pg8::Unit& u, int wr, int wc, int fr, int fq) const {
        const int col0 = u.pn * 256 + wc * 64 + fq * 8;
#pragma unroll
        for (int ai = 0; ai < 2; ++ai)
#pragma unroll
            for (int m = 0; m < 4; ++m) {
                const int row = u.pm * 256 + ai * 128 + wr * 64 + m * 16 + fr;
                const int b = row_batch(row);
                float* o = out + (size_t)row * D + col0;
                bf16_t* xb = x1b + (size_t)row * D + col0;
                const float* gp = mod + (size_t)b * 6144 + goff + col0;
#pragma unroll
                for (int bj = 0; bj < 2; ++bj) {
                    const f32x4 g0 = *(const f32x4*)(gp + bj * 32), g1 = *(const f32x4*)(gp + bj * 32 + 4);
                    if (INPLACE) {
                        if (u.kq >= 0) {
                            const f32x4 d0 = g0 * acc[ai][bj][m][0], d1 = g1 * acc[ai][bj][m][1]; float* q = o + bj * 32;
                            unsafeAtomicAdd(q, d0.x); unsafeAtomicAdd(q + 1, d0.y); unsafeAtomicAdd(q + 2, d0.z); unsafeAtomicAdd(q + 3, d0.w);
                            unsafeAtomicAdd(q + 4, d1.x); unsafeAtomicAdd(q + 5, d1.y); unsafeAtomicAdd(q + 6, d1.z); unsafeAtomicAdd(q + 7, d1.w);
                        } else {
                            const u32x4 w = *(const u32x4*)(xb + bj * 32);
                            const f32x4 x0 = (f32x4){__uint_as_float(w.x << 16), __uint_as_float(w.x & 0xffff0000u), __uint_as_float(w.y << 16), __uint_as_float(w.y & 0xffff0000u)};
                            const f32x4 x1 = (f32x4){__uint_as_float(w.z << 16), __uint_as_float(w.z & 0xffff0000u), __uint_as_float(w.w << 16), __uint_as_float(w.w & 0xffff0000u)};
                            *(f32x4*)(o + bj * 32) = x0 + g0 * acc[ai][bj][m][0]; *(f32x4*)(o + bj * 32 + 4) = x1 + g1 * acc[ai][bj][m][1];
                        }
                    } else {
                        const float* base = (row < MP ? xp + (size_t)row * D : xs + (size_t)(row - MP) * D) + col0 + bj * 32;
                        const f32x4 y0 = *(const f32x4*)base + g0 * acc[ai][bj][m][0], y1 = *(const f32x4*)(base + 4) + g1 * acc[ai][bj][m][1];
                        u32x4 w; w.x = cvt_pk_bf16(y0.x, y0.y); w.y = cvt_pk_bf16(y0.z, y0.w); w.z = cvt_pk_bf16(y1.x, y1.y); w.w = cvt_pk_bf16(y1.z, y1.w);
                        *(u32x4*)(xb + bj * 32) = w;
                        if (u.pm == 256) { *(f32x4*)(o + bj * 32) = y0; *(f32x4*)(o + bj * 32 + 4) = y1; }
                    }
                }
            }
    }
};
struct EpiUp {
    static constexpr bool PERM = false, AFTER_DRAIN = false;
    bf16_t* hid;
    __device__ __forceinline__ void operator()(const f32x4 (&acc)[2][2][4][2], const pg8::Unit& u, int wr, int wc, int fr, int fq) const {
        const int col0 = u.pn * 256 + wc * 64 + fq * 8;
#pragma unroll
        for (int ai = 0; ai < 2; ++ai)
#pragma unroll
            for (int m = 0; m < 4; ++m) {
                const int row = u.pm * 256 + ai * 128 + wr * 64 + m * 16 + fr;
                bf16_t* o = hid + (size_t)row * DFF + col0;
#pragma unroll
                for (int bj = 0; bj < 2; ++bj) { f32x4 a = acc[ai][bj][m][0], c = acc[ai][bj][m][1];
                    a = __builtin_elementwise_max(a, (f32x4){0.f, 0.f, 0.f, 0.f}); c = __builtin_elementwise_max(c, (f32x4){0.f, 0.f, 0.f, 0.f}); a = a * a; c = c * c;
                    u32x4 w; w.x = cvt_pk_bf16(a.x, a.y); w.y = cvt_pk_bf16(a.z, a.w); w.z = cvt_pk_bf16(c.x, c.y); w.w = cvt_pk_bf16(c.z, c.w);
                    *(u32x4*)(o + bj * 32) = w; }
            }
    }
};

constexpr int G_RAW = 0, G_QS = 29184, G_KS = G_QS + 8192, G_VS = G_KS + 8192, G_OS = G_VS + 8192, G_PART = G_OS + 8192, G_CW = G_PART + 8192, G_SA = G_CW + 6144, G_SB = G_SA + 64, G_QK = G_SB + 64;
__device__ __forceinline__ void gdn_item(const Params& p, LAS unsigned char* L, int rowbase, int T, int h, const float* s0, const float* left, float* sout, int tid_in, int wave, int lane_in) {
    const int tid = opq(tid_in), lane = tid & 63;
    const bf16_t* proj = (const bf16_t*)(p.ws + WS_PROJ);
    const float* BA = (const float*)(p.ws + WS_BA);
    bf16_t* mix = (bf16_t*)(p.ws + WS_MIX);
    LAS float* raw = (LAS float*)(L + G_RAW); LAS float* qs = (LAS float*)(L + G_QS); LAS float* ks = (LAS float*)(L + G_KS); LAS float* vs = (LAS float*)(L + G_VS);
    LAS float* os = (LAS float*)(L + G_OS); LAS f32x2* part = (LAS f32x2*)(L + G_PART); LAS float* cw = (LAS float*)(L + G_CW);
    LAS float* sa = (LAS float*)(L + G_SA); LAS float* sb = (LAS float*)(L + G_SB); LAS float* sqk = (LAS float*)(L + G_QK);
    const int dv = tid & 127, kg = tid >> 7;
    float S[32];
#pragma unroll
    for (int i = 0; i < 32; ++i) S[i] = s0 ? s0[(size_t)(kg * 32 + i) * 128 + dv] : 0.f;
    const float* convw = p.in[13];
    for (int i = tid; i < 4 * 384; i += NTHREADS) { const int tap = i / 384, ch = i % 384; cw[i] = convw[tap * 1536 + (ch >> 7) * 512 + h * 128 + (ch & 127)]; }
    const float nAexp = -__expf(p.in[14][h]), dtb = p.in[15][h];
    const float gn0 = p.in[16][lane], gn1 = p.in[16][lane + 64];
    int buf = 0;
    for (int t0 = 0; t0 < T; t0 += 16) {
        for (int i = tid; i < 19 * 48; i += NTHREADS) {
            const int r = i / 48, seg = i % 48, part_ = seg >> 4, off = (seg & 15) * 8, t = t0 - 3 + r;
            float v8[8];
            if (t >= 0) { const u32x4 w = *(const u32x4*)(proj + (size_t)(rowbase + t) * NPROJ + part_ * 512 + h * 128 + off);
                v8[0] = __uint_as_float(w.x << 16); v8[1] = __uint_as_float(w.x & 0xffff0000u); v8[2] = __uint_as_float(w.y << 16); v8[3] = __uint_as_float(w.y & 0xffff0000u);
                v8[4] = __uint_as_float(w.z << 16); v8[5] = __uint_as_float(w.z & 0xffff0000u); v8[6] = __uint_as_float(w.w << 16); v8[7] = __uint_as_float(w.w & 0xffff0000u); }
            else if (left) { const float* lp = left + (size_t)(3 + t) * 1536 + part_ * 512 + h * 128 + off;
#pragma unroll
                for (int e = 0; e < 8; ++e) v8[e] = lp[e]; }
            else {
#pragma unroll
                for (int e = 0; e < 8; ++e) v8[e] = 0.f; }
            LAS float* d = raw + r * 384 + part_ * 128 + off;
            *(LAS f32x4*)d = (f32x4){v8[0], v8[1], v8[2], v8[3]}; *(LAS f32x4*)(d + 4) = (f32x4){v8[4], v8[5], v8[6], v8[7]};
        }
        __syncthreads();
        for (int i = tid; i < 16 * 384; i += NTHREADS) {
            const int tok = i / 384, ch = i % 384;
            const float a = cw[ch] * raw[tok * 384 + ch] + cw[384 + ch] * raw[(tok + 1) * 384 + ch] + cw[768 + ch] * raw[(tok + 2) * 384 + ch] + cw[1152 + ch] * raw[(tok + 3) * 384 + ch];
            const float y = silu_f(a);
            LAS float* dst = (ch < 128) ? qs : (ch < 256 ? ks : vs);
            dst[tok * 128 + (ch & 127)] = y;
        }
        __syncthreads();
#pragma unroll
        for (int rr = 0; rr < 2; ++rr) {
            const int tok = wave + 8 * rr;
            const float q0 = qs[tok * 128 + lane], q1 = qs[tok * 128 + lane + 64], k0 = ks[tok * 128 + lane], k1 = ks[tok * 128 + lane + 64];
            const float sq = wave_sum(q0 * q0 + q1 * q1), sk = wave_sum(k0 * k0 + k1 * k1), qk = wave_sum(q0 * k0 + q1 * k1);
            const float rq = rsqrtf(sq + EPS) * 0.08838834764831845f, rk = rsqrtf(sk + EPS);
            qs[tok * 128 + lane] = q0 * rq; qs[tok * 128 + lane + 64] = q1 * rq; ks[tok * 128 + lane] = k0 * rk; ks[tok * 128 + lane + 64] = k1 * rk;
            if (lane == 0) {
                const size_t row = (size_t)(rowbase + t0 + tok);
                const float braw = BA[row * 8 + h], araw = BA[row * 8 + 4 + h] + dtb;
                const float sp = araw > 20.f ? araw : log1pf(__expf(araw));
                sa[tok] = __expf(nAexp * sp); sb[tok] = 1.f / (1.f + __expf(-braw)); sqk[tok] = qk * rq * rk;
            }
        }
        __syncthreads();
        for (int tok = 0; tok < 16; ++tok) {
            f32x4 kk[8], qq[8];
#pragma unroll
            for (int i = 0; i < 8; ++i) { kk[i] = *(const LAS f32x4*)(ks + tok * 128 + kg * 32 + 4 * i); qq[i] = *(const LAS f32x4*)(qs + tok * 128 + kg * 32 + 4 * i); }
            float pk = 0.f, pq = 0.f;
#pragma unroll
            for (int i = 0; i < 8; ++i) {
                pk += kk[i].x * S[4 * i] + kk[i].y * S[4 * i + 1] + kk[i].z * S[4 * i + 2] + kk[i].w * S[4 * i + 3];
                pq += qq[i].x * S[4 * i] + qq[i].y * S[4 * i + 1] + qq[i].z * S[4 * i + 2] + qq[i].w * S[4 * i + 3]; }
            part[(buf * 4 + kg) * 128 + dv] = (f32x2){pk, pq};
            __syncthreads();
            const f32x2 p0 = part[(buf * 4 + 0) * 128 + dv], p1 = part[(buf * 4 + 1) * 128 + dv], p2 = part[(buf * 4 + 2) * 128 + dv], p3 = part[(buf * 4 + 3) * 128 + dv];
            const float kS = (p0.x + p1.x) + (p2.x + p3.x), qS = (p0.y + p1.y) + (p2.y + p3.y);
            const float a = sa[tok], bt = sb[tok], qkv = sqk[tok], vv = vs[tok * 128 + dv];
            const float dlt = bt * (vv - a * kS);
#pragma unroll
            for (int i = 0; i < 8; ++i) {
                S[4 * i] = a * S[4 * i] + kk[i].x * dlt; S[4 * i + 1] = a * S[4 * i + 1] + kk[i].y * dlt; S[4 * i + 2] = a * S[4 * i + 2] + kk[i].z * dlt; S[4 * i + 3] = a * S[4 * i + 3] + kk[i].w * dlt; }
            if (kg == 0) os[tok * 128 + dv] = a * qS + qkv * dlt;
            buf ^= 1;
        }
        __syncthreads();
#pragma unroll
        for (int rr = 0; rr < 2; ++rr) {
            const int tok = wave + 8 * rr; const size_t row = (size_t)(rowbase + t0 + tok);
            const float o0 = os[tok * 128 + lane], o1 = os[tok * 128 + lane + 64];
            const float rstd = rsqrtf(wave_sum(o0 * o0 + o1 * o1) * (1.f / 128.f) + EPS);
            const float g0 = bf2f(proj[row * NPROJ + C_GA + h * 128 + lane]), g1 = bf2f(proj[row * NPROJ + C_GA + h * 128 + lane + 64]);
            mix[row * D + h * 128 + lane] = f2bf(o0 * rstd * gn0 * silu_f(g0));
            mix[row * D + h * 128 + lane + 64] = f2bf(o1 * rstd * gn1 * silu_f(g1));
        }
    }
#pragma unroll
    for (int i = 0; i < 32; ++i) sout[(size_t)(kg * 32 + i) * 128 + dv] = S[i];
    __syncthreads();
}

template <int J, int... II> __device__ __forceinline__ void fs_col_apply(float (&x)[32], const float (&mv)[2], std::integer_sequence<int, II...>) {
    (fmac_bc<(J + 1 + II) & 15>(x[J + 1 + II], mv[(J + 1 + II) >> 4], x[J]), ...);
}
template <int J> __device__ __forceinline__ void fs_col_load(float (&mv)[2], const LAS float* Mb, int l15) {
#pragma unroll
    for (int q = 0; q < 2; ++q) if (16 * q + 15 > J) mv[q] = Mb[(16 * q + l15) * 68 + J];
}
template <int J> __device__ __forceinline__ void fs_col(float (&x)[32], float (&mvc)[2], const LAS float* Mb, int l15) {
    float mvn[2] = {0.f, 0.f};
    if constexpr (J + 1 < 31) fs_col_load<J + 1>(mvn, Mb, l15);
    fs_col_apply<J>(x, mvc, std::make_integer_sequence<int, 31 - J>{});
#pragma unroll
    for (int q = 0; q < 2; ++q) mvc[q] = mvn[q];
}
template <int... JJ> __device__ __forceinline__ void fs_all(float (&x)[32], const LAS float* Mb, int l15, std::integer_sequence<int, JJ...>) {
    float mvc[2] = {0.f, 0.f}; fs_col_load<0>(mvc, Mb, l15); (fs_col<JJ>(x, mvc, Mb, l15), ...);
}
constexpr int CS_Q = 136, CS_VU = 132, CS_M = 68, CS_T = 72;
constexpr int C_M = 0, C_Q = 17408, C_QG = 34816, C_K = 52224, C_KDT = 69632, C_VU = 88064, C_QKM = 121856, C_SC = 131072;
#define LDS_BARRIER() do { asm volatile("s_waitcnt lgkmcnt(0)" ::: "memory"); __builtin_amdgcn_s_barrier(); asm volatile("" ::: "memory"); } while (0)
__device__ __forceinline__ void gdn_chunk_item(const Params& p, LAS unsigned char* L, int b, int h, float* sout, int tid_unused, int wave, int lane_in) {
    int lane = opq(lane_in);
    const bf16_t* proj = (const bf16_t*)(p.ws + WS_PROJ);
    const float* BA = (const float*)(p.ws + WS_BA);
    bf16_t* mix = (bf16_t*)(p.ws + WS_MIX);
    LAS bf16_t* Qb = (LAS bf16_t*)(L + C_Q); LAS bf16_t* QGb = (LAS bf16_t*)(L + C_QG); LAS bf16_t* Kb = (LAS bf16_t*)(L + C_K); LAS bf16_t* KDt = (LAS bf16_t*)(L + C_KDT);
    LAS float* VU = (LAS float*)(L + C_VU); LAS float* Mm = (LAS float*)(L + C_M); LAS bf16_t* QKm = (LAS bf16_t*)(L + C_QKM);
    LAS float* sgc = (LAS float*)(L + C_SC); LAS float* sbeta = sgc + 64; LAS float* sbg = sgc + 128;
    LAS bf16_t* Wb = Qb;
    int fr = lane & 15, g = lane >> 4;
    const size_t rowbase = (size_t)b * TP;
    float cw[4][3][2];
#pragma unroll
    for (int tap = 0; tap < 4; ++tap)
#pragma unroll
        for (int pt = 0; pt < 3; ++pt) { const f32x2 t = *(const f32x2*)(p.in[13] + tap * 1536 + pt * 512 + h * 128 + 2 * lane); cw[tap][pt][0] = t.x; cw[tap][pt][1] = t.y; }
    const float nAexp = -__expf(p.in[14][h]), dtb = p.in[15][h];
    const f32x2 gn = *(const f32x2*)(p.in[16] + 2 * lane);
    f32x4 Sacc[8];
#pragma unroll
    for (int i = 0; i < 8; ++i) Sacc[i] = (f32x4){0.f, 0.f, 0.f, 0.f};
    float pf_b, pf_a; unsigned pf_raw[11][3], pf_gate[8];
#define GDN_PREFETCH(T0) do { const int t0n_ = (T0); \
        { const size_t row_ = rowbase + t0n_ + lane; pf_b = BA[row_ * 8 + h]; pf_a = BA[row_ * 8 + 4 + h]; } \
        _Pragma("unroll") for (int r = 0; r < 11; ++r) { const int tr = t0n_ + 8 * wave - 3 + r; \
            _Pragma("unroll") for (int pt = 0; pt < 3; ++pt) pf_raw[r][pt] = (tr >= 0) ? *(const unsigned*)(proj + (rowbase + tr) * NPROJ + pt * 512 + h * 128 + 2 * lane) : 0u; } \
        _Pragma("unroll") for (int j = 0; j < 8; ++j) pf_gate[j] = *(const unsigned*)(proj + (rowbase + t0n_ + 8 * wave + j) * NPROJ + C_GA + h * 128 + 2 * lane); } while (0)
    GDN_PREFETCH(0);
    for (int c = 0; c < 32; ++c) {
        const int t0 = c * 64;
        lane = opq(lane_in);
        float beta, gcs, gam, kdl, glast, gl0, gl1;
        {
            const float braw = pf_b, araw = pf_a + dtb;
            const float sp = araw > 20.f ? araw : __logf(1.f + __expf(araw));
            gcs = nAexp * sp; beta = sigmoid_f(braw);
            gcs += dpp_f<0x111>(gcs); gcs += dpp_f<0x112>(gcs); gcs += dpp_f<0x114>(gcs); gcs += dpp_f<0x118>(gcs);
            { const float t15 = __int_as_float(__builtin_amdgcn_readlane(__float_as_int(gcs), 15)), t47 = __int_as_float(__builtin_amdgcn_readlane(__float_as_int(gcs), 47));
              if (lane & 16) gcs += (lane < 32) ? t15 : t47; }
            gl0 = __int_as_float(__builtin_amdgcn_readlane(__float_as_int(gcs), 31)); gl1 = __int_as_float(__builtin_amdgcn_readlane(__float_as_int(gcs), 63)); glast = lane < 32 ? gl0 : gl1;
            gam = __expf(gcs); kdl = __expf(glast - gcs);
            if (wave == 0) { sgc[lane] = gcs; sbeta[lane] = beta; sbg[lane] = beta * gam; }
        }
        unsigned gatev[8];
        {
#pragma unroll
            for (int j = 0; j < 8; ++j) gatev[j] = pf_gate[j];
#pragma unroll
            for (int j = 0; j < 8; ++j) {
                const int tok = 8 * wave + j;
                float y[3][2];
#pragma unroll
                for (int pt = 0; pt < 3; ++pt) { float a0 = 0.f, a1 = 0.f;
#pragma unroll
                    for (int tap = 0; tap < 4; ++tap) { const unsigned u = pf_raw[j + tap][pt]; a0 += cw[tap][pt][0] * __uint_as_float(u << 16); a1 += cw[tap][pt][1] * __uint_as_float(u & 0xffff0000u); }
                    y[pt][0] = silu_f(a0); y[pt][1] = silu_f(a1); }
                const float rq = rsqrtf(wave_sum_u(y[0][0] * y[0][0] + y[0][1] * y[0][1]) + EPS) * 0.08838834764831845f;
                const float rk = rsqrtf(wave_sum_u(y[1][0] * y[1][0] + y[1][1] * y[1][1]) + EPS);
                const float gm = __int_as_float(__builtin_amdgcn_readlane(__float_as_int(gam), tok)), bt = __int_as_float(__builtin_amdgcn_readlane(__float_as_int(beta), tok)), kd = __int_as_float(__builtin_amdgcn_readlane(__float_as_int(kdl), tok));
                const float q0 = y[0][0] * rq, q1 = y[0][1] * rq, k0 = y[1][0] * rk, k1 = y[1][1] * rk;
                *(LAS unsigned*)(Qb + tok * CS_Q + 2 * lane) = cvt_pk_bf16(q0, q1);
                *(LAS unsigned*)(QGb + tok * CS_Q + 2 * lane) = cvt_pk_bf16(q0 * gm, q1 * gm);
                *(LAS unsigned*)(Kb + tok * CS_Q + 2 * lane) = cvt_pk_bf16(k0, k1);
                const unsigned kdp = cvt_pk_bf16(k0 * kd, k1 * kd);
                KDt[(2 * lane) * CS_T + tok] = (bf16_t)(kdp & 0xffffu); KDt[(2 * lane + 1) * CS_T + tok] = (bf16_t)(kdp >> 16);
                *(LAS f32x2*)(VU + tok * CS_VU + 2 * lane) = (f32x2){bt * y[2][0], bt * y[2][1]};
            }
            if (c + 1 < 32) GDN_PREFETCH(t0 + 64);
        }
        LDS_BARRIER();
        lane = opq(lane_in); fr = lane & 15; g = lane >> 4; const int tid = wave * 64 + lane;
        { const int hf = tid >> 8, i = (tid >> 4) & 15, j = tid & 15; QKm[(32 * hf + i) * CS_T + 32 * hf + 16 + j] = 0; }
        for (int tix = wave; tix < 12; tix += 8) {
            const int kind = tix >= 6 ? 1 : 0, tl = tix - 6 * kind;
            const int it = tl < 3 ? (tl >= 1 ? 1 : 0) : (tl >= 4 ? 3 : 2), jt = tl < 3 ? (tl == 2 ? 1 : 0) : (tl == 5 ? 3 : 2);
            const LAS bf16_t* As = kind ? Qb : Kb;
            f32x4 acc = (f32x4){0.f, 0.f, 0.f, 0.f};
#pragma unroll
            for (int ks = 0; ks < 4; ++ks) { const bf16x8 a = *(const LAS bf16x8*)(As + (it * 16 + fr) * CS_Q + ks * 32 + g * 8), bb = *(const LAS bf16x8*)(Kb + (jt * 16 + fr) * CS_Q + ks * 32 + g * 8);
                acc = __builtin_amdgcn_mfma_f32_16x16x32_bf16(a, bb, acc, 0, 0, 0); }
            const int j = jt * 16 + fr; const float gcj = sgc[j];
#pragma unroll
            for (int r = 0; r < 4; ++r) { const int i = it * 16 + 4 * g + r; const float dec = __expf(fminf(sgc[i] - gcj, 0.f));
                if (kind == 0) Mm[i * CS_M + j] = (i > j) ? -(acc[r] * dec * sbeta[i]) : 0.f;
                else QKm[i * CS_T + j] = (i >= j) ? f2bf(acc[r] * dec) : (bf16_t)0; }
        }
        LDS_BARRIER();
        {
            float x[32];
            const int l3 = opq(lane_in), sub = wave >> 2, wq = wave & 3, cc = (wq & 1) * 64 + l3, r0 = 32 * sub;
            if (wq < 2) {
#pragma unroll
                for (int i = 0; i < 32; ++i) x[i] = VU[(r0 + i) * CS_VU + cc];
            } else {
#pragma unroll
                for (int i = 0; i < 32; ++i) x[i] = bf2f(Kb[(r0 + i) * CS_Q + cc]) * sbg[r0 + i];
            }
            fs_all(x, Mm + r0 * CS_M + r0, l3 & 15, std::make_integer_sequence<int, 31>{});
            if (wq < 2) {
#pragma unroll
                for (int i = 0; i < 32; ++i) VU[(r0 + i) * CS_VU + cc] = x[i];
            } else {
#pragma unroll
                for (int i = 0; i < 32; ++i) Wb[(r0 + i) * CS_Q + cc] = f2bf(-x[i]);
            }
        }
        LDS_BARRIER();
        lane = opq(lane_in); fr = lane & 15; g = lane >> 4;
#pragma unroll
        for (int sub = 0; sub < 2; ++sub) {
            const float glw = __expf(sub ? gl1 : gl0);
            f32x4 ua[2]; u32x2 wf[2][4][2], qf[2][4][2], mf[2][2], kf[8][2];
#pragma unroll
            for (int t2 = 0; t2 < 2; ++t2) { const int tt = 2 * sub + t2;
#pragma unroll
                for (int r = 0; r < 4; ++r) ua[t2][r] = VU[(tt * 16 + 4 * g + r) * CS_VU + 16 * wave + fr];
#pragma unroll
                for (int ks = 0; ks < 4; ++ks) { const LAS bf16_t* wp = Wb + (tt * 16 + fr) * CS_Q + ks * 32 + 4 * g; const LAS bf16_t* qp = QGb + (tt * 16 + fr) * CS_Q + ks * 32 + 4 * g;
                    wf[t2][ks][0] = *(const LAS u32x2*)wp; wf[t2][ks][1] = *(const LAS u32x2*)(wp + 16); qf[t2][ks][0] = *(const LAS u32x2*)qp; qf[t2][ks][1] = *(const LAS u32x2*)(qp + 16); } }
            asm volatile("s_waitcnt lgkmcnt(0)" ::: "memory");
            bf16x8 Sb[4];
#pragma unroll
            for (int ks = 0; ks < 4; ++ks) { const f32x4 lo = Sacc[2 * ks], hi = Sacc[2 * ks + 1];
                const u32x4 w = (u32x4){cvt_pk_bf16(lo.x, lo.y), cvt_pk_bf16(lo.z, lo.w), cvt_pk_bf16(hi.x, hi.y), cvt_pk_bf16(hi.z, hi.w)}; Sb[ks] = __builtin_bit_cast(bf16x8, w); }
            f32x4 vn[2], oo[2];
#pragma unroll
            for (int t2 = 0; t2 < 2; ++t2) { vn[t2] = ua[t2]; oo[t2] = (f32x4){0.f, 0.f, 0.f, 0.f}; }
#pragma unroll
            for (int ks = 0; ks < 4; ++ks)
#pragma unroll
                for (int t2 = 0; t2 < 2; ++t2) {
                    const u32x4 wa = (u32x4){wf[t2][ks][0].x, wf[t2][ks][0].y, wf[t2][ks][1].x, wf[t2][ks][1].y}, qa = (u32x4){qf[t2][ks][0].x, qf[t2][ks][0].y, qf[t2][ks][1].x, qf[t2][ks][1].y};
                    vn[t2] = __builtin_amdgcn_mfma_f32_16x16x32_bf16(__builtin_bit_cast(bf16x8, wa), Sb[ks], vn[t2], 0, 0, 0);
                    oo[t2] = __builtin_amdgcn_mfma_f32_16x16x32_bf16(__builtin_bit_cast(bf16x8, qa), Sb[ks], oo[t2], 0, 0, 0);
                }
            __builtin_amdgcn_sched_barrier(0);
#pragma unroll
            for (int t2 = 0; t2 < 2; ++t2) { const LAS bf16_t* ap = QKm + ((2 * sub + t2) * 16 + fr) * CS_T + 32 * sub + 4 * g; mf[t2][0] = *(const LAS u32x2*)ap; mf[t2][1] = *(const LAS u32x2*)(ap + 16); }
#pragma unroll
            for (int dkt = 0; dkt < 8; ++dkt) { const LAS bf16_t* ap = KDt + (dkt * 16 + fr) * CS_T + 32 * sub + 4 * g; kf[dkt][0] = *(const LAS u32x2*)ap; kf[dkt][1] = *(const LAS u32x2*)(ap + 16); }
            asm volatile("s_waitcnt lgkmcnt(0)" ::: "memory");
            bf16x8 Vb;
            { const f32x4 lo = vn[0], hi = vn[1];
                const u32x4 w = (u32x4){cvt_pk_bf16(lo.x, lo.y), cvt_pk_bf16(lo.z, lo.w), cvt_pk_bf16(hi.x, hi.y), cvt_pk_bf16(hi.z, hi.w)}; Vb = __builtin_bit_cast(bf16x8, w); }
#pragma unroll
            for (int dkt = 0; dkt < 8; ++dkt) { const u32x4 aa = (u32x4){kf[dkt][0].x, kf[dkt][0].y, kf[dkt][1].x, kf[dkt][1].y};
                Sacc[dkt] = __builtin_amdgcn_mfma_f32_16x16x32_bf16(__builtin_bit_cast(bf16x8, aa), Vb, Sacc[dkt] * glw, 0, 0, 0); }
#pragma unroll
            for (int t2 = 0; t2 < 2; ++t2) { const int tt = 2 * sub + t2;
                const u32x4 aa = (u32x4){mf[t2][0].x, mf[t2][0].y, mf[t2][1].x, mf[t2][1].y};
                const f32x4 o = __builtin_amdgcn_mfma_f32_16x16x32_bf16(__builtin_bit_cast(bf16x8, aa), Vb, oo[t2], 0, 0, 0);
#pragma unroll
                for (int r = 0; r < 4; ++r) VU[(tt * 16 + 4 * g + r) * CS_VU + 16 * wave + fr] = o[r]; }
        }
        LDS_BARRIER();
        lane = opq(lane_in);
#pragma unroll
        for (int j = 0; j < 8; ++j) {
            const int tok = 8 * wave + j;
            const f32x2 o = *(const LAS f32x2*)(VU + tok * CS_VU + 2 * lane);
            const float rstd = rsqrtf(wave_sum_u(o.x * o.x + o.y * o.y) * (1.f / 128.f) + EPS);
            const float g0 = __uint_as_float(gatev[j] << 16), g1 = __uint_as_float(gatev[j] & 0xffff0000u);
            *(unsigned*)(mix + (rowbase + t0 + tok) * D + h * 128 + 2 * lane) = cvt_pk_bf16(o.x * rstd * gn.x * silu_f(g0), o.y * rstd * gn.y * silu_f(g1));
        }
    }
    lane = opq(lane_in); fr = lane & 15; g = lane >> 4;
#pragma unroll
    for (int dkt = 0; dkt < 8; ++dkt)
#pragma unroll
        for (int r = 0; r < 4; ++r) sout[(size_t)(dkt * 16 + 4 * g + r) * 128 + 16 * wave + fr] = Sacc[dkt][r];
#undef GDN_PREFETCH
    __syncthreads();
}

constexpr int A_TB = 132096;
__device__ __forceinline__ void attn_prompt_item(const Params& p, LAS unsigned char* L, int b, int c, int wave, int lane_in) {
    const int lane = opq(lane_in);
    const bf16_t* proj = (const bf16_t*)(p.ws + WS_PROJ);
    const bf16_t* vt = (const bf16_t*)(p.ws + WS_VT);
    bf16_t* mix = (bf16_t*)(p.ws + WS_MIX);
    const int h = wave, fr = lane & 15, g = lane >> 4;
    const LAS float* Tb = (const LAS float*)(L + A_TB) + h * 320;
    const size_t rowq0 = (size_t)b * TP + c * 64;
    bf16x8 Qf[4][2];
#pragma unroll
    for (int qt = 0; qt < 4; ++qt)
#pragma unroll
        for (int ks = 0; ks < 2; ++ks) Qf[qt][ks] = *(const bf16x8*)(proj + (rowq0 + qt * 16 + fr) * NPROJ + C_QB + h * 64 + ks * 32 + g * 8);
    f32x4 O[4][4]; float ls[4];
#pragma unroll
    for (int dt = 0; dt < 4; ++dt)
#pragma unroll
        for (int qt = 0; qt < 4; ++qt) O[dt][qt] = (f32x4){0.f, 0.f, 0.f, 0.f};
#pragma unroll
    for (int qt = 0; qt < 4; ++qt) ls[qt] = 0.f;
    const int jc0 = (c < 8) ? (8 - c) : 0;
    bf16x8 Kn[2][2], Vn[4];
#define ATT_LOAD(JT) do { const int tok0_ = c * 64 - 512 + (JT) * 32; \
        _Pragma("unroll") for (int kt = 0; kt < 2; ++kt) _Pragma("unroll") for (int ks = 0; ks < 2; ++ks) \
            Kn[kt][ks] = *(const bf16x8*)(proj + ((size_t)b * TP + tok0_ + kt * 16 + fr) * NPROJ + C_KB + h * 64 + ks * 32 + g * 8); \
        _Pragma("unroll") for (int dt = 0; dt < 4; ++dt) { const bf16_t* vp = vt + ((size_t)b * 512 + h * 64 + dt * 16 + fr) * 2048 + tok0_ + 4 * g; \
            const u32x2 lo = *(const u32x2*)vp, hi = *(const u32x2*)(vp + 16); const u32x4 w = (u32x4){lo.x, lo.y, hi.x, hi.y}; Vn[dt] = __builtin_bit_cast(bf16x8, w); } } while (0)
    ATT_LOAD(jc0 * 2);
    for (int jt = jc0 * 2; jt < 18; ++jt) {
        const int kj0 = jt * 32;
        bf16x8 Kf[2][2], Vf[4];
#pragma unroll
        for (int kt = 0; kt < 2; ++kt)
#pragma unroll
            for (int ks = 0; ks < 2; ++ks) Kf[kt][ks] = Kn[kt][ks];
#pragma unroll
        for (int dt = 0; dt < 4; ++dt) Vf[dt] = Vn[dt];
        if (jt + 1 < 18) ATT_LOAD(jt + 1);
        f32x4 St[2][4];
#pragma unroll
        for (int kt = 0; kt < 2; ++kt)
#pragma unroll
            for (int qt = 0; qt < 4; ++qt) { St[kt][qt] = (f32x4){0.f, 0.f, 0.f, 0.f};
#pragma unroll
                for (int ks = 0; ks < 2; ++ks) St[kt][qt] = __builtin_amdgcn_mfma_f32_16x16x32_bf16(Kf[kt][ks], Qf[qt][ks], St[kt][qt], 0, 0, 0); }
        bf16x8 Pf[4];
#pragma unroll
        for (int qt = 0; qt < 4; ++qt) {
            float e[8];
            if (jt < 8) {
                const float tb = Tb[319];
#pragma unroll
                for (int kt = 0; kt < 2; ++kt)
#pragma unroll
                    for (int r = 0; r < 4; ++r) { const float x = __builtin_amdgcn_exp2f(St[kt][qt][r] + tb); e[kt * 4 + r] = x; ls[qt] += x; }
            } else {
#pragma unroll
            for (int kt = 0; kt < 2; ++kt)
#pragma unroll
                for (int r = 0; r < 4; ++r) { const int key = kt * 16 + 4 * g + r, qi = qt * 16 + fr; int idx = qi - (kj0 + key) + 575; idx = idx > 319 ? 319 : idx;
                    const float x = __builtin_amdgcn_exp2f(St[kt][qt][r] + Tb[idx]); e[kt * 4 + r] = x; ls[qt] += x; }
            }
            const u32x4 w = (u32x4){cvt_pk_bf16(e[0], e[1]), cvt_pk_bf16(e[2], e[3]), cvt_pk_bf16(e[4], e[5]), cvt_pk_bf16(e[6], e[7])};
            Pf[qt] = __builtin_bit_cast(bf16x8, w);
        }
#pragma unroll
        for (int dt = 0; dt < 4; ++dt)
#pragma unroll
            for (int qt = 0; qt < 4; ++qt) O[dt][qt] = __builtin_amdgcn_mfma_f32_16x16x32_bf16(Vf[dt], Pf[qt], O[dt][qt], 0, 0, 0);
    }
#undef ATT_LOAD
#pragma unroll
    for (int qt = 0; qt < 4; ++qt) {
        float l = ls[qt]; l += __shfl_xor(l, 16); l += __shfl_xor(l, 32); const float inv = 1.f / l;
        bf16_t* o = mix + (rowq0 + qt * 16 + fr) * D + 512 + h * 64 + 4 * g;
#pragma unroll
        for (int dt = 0; dt < 4; ++dt) { const f32x4 v = O[dt][qt] * inv; u32x2 w; w.x = cvt_pk_bf16(v.x, v.y); w.y = cvt_pk_bf16(v.z, v.w); *(u32x2*)(o + dt * 16) = w; }
    }
}

constexpr int SA_Q = 0, SA_SC = 4096, SA_RI = SA_SC + 16 * 528 * 4;
__device__ __forceinline__ void attn_sample_item(const Params& p, LAS unsigned char* L, int sbi, int h, int tid_in, int wave, int lane_in) {
    const int tid = opq(tid_in), lane = tid & 63;
    const bf16_t* proj = (const bf16_t*)(p.ws + WS_PROJ);
    bf16_t* mix = (bf16_t*)(p.ws + WS_MIX);
    const float* ck = p.in[4]; const float* cv = p.in[5]; const float* rb = p.in[19] + h * 320;
    LAS float* qs = (LAS float*)(L + SA_Q); LAS float* sc = (LAS float*)(L + SA_SC); LAS float* ri = (LAS float*)(L + SA_RI);
    const size_t row0 = (size_t)MP + sbi * 16;
    for (int i = tid; i < 1024; i += NTHREADS) qs[i] = bf2f(proj[(row0 + (i >> 6)) * NPROJ + C_QB + h * 64 + (i & 63)]);
    __syncthreads();
#pragma unroll 1
    for (int pass = 0; pass < 2; ++pass) {
        const int j = pass * 512 + tid;
        if (j < 528) {
            float kr[64];
            if (pass == 0) { const float* kp = ck + (((size_t)sbi * 512 + j) * 8 + h) * 64;
#pragma unroll
                for (int d = 0; d < 16; ++d) { const f32x4 t = *(const f32x4*)(kp + 4 * d); kr[4 * d] = t.x; kr[4 * d + 1] = t.y; kr[4 * d + 2] = t.z; kr[4 * d + 3] = t.w; } }
            else { const bf16_t* kp = proj + (row0 + (j - 512)) * NPROJ + C_KB + h * 64;
#pragma unroll
                for (int d = 0; d < 64; ++d) kr[d] = bf2f(kp[d]); }
            for (int qi = 0; qi < 16; ++qi) {
                float s = 0.f;
#pragma unroll
                for (int d = 0; d < 16; ++d) { const f32x4 q = *(const LAS f32x4*)(qs + qi * 64 + 4 * d); s += (q.x * kr[4 * d] + q.y * kr[4 * d + 1]) + (q.z * kr[4 * d + 2] + q.w * kr[4 * d + 3]); }
                int dd = qi + 512 - j; dd = dd > 256 ? 256 : dd;
                sc[qi * 528 + j] = s + rb[dd + 63] * LOG2E;
            }
        }
    }
    __syncthreads();
#pragma unroll
    for (int rr = 0; rr < 2; ++rr) {
        const int qi = 2 * wave + rr; float m = -3.0e38f;
        for (int j = lane; j < 528; j += 64) m = fmaxf(m, sc[qi * 528 + j]);
        m = wave_max(m); float s = 0.f;
        for (int j = lane; j < 528; j += 64) { const float e = __builtin_amdgcn_exp2f(sc[qi * 528 + j] - m); sc[qi * 528 + j] = e; s += e; }
        s = wave_sum(s); if (lane == 0) ri[qi] = 1.f / s;
    }
    __syncthreads();
    {
        const int dv = tid & 63, ig = tid >> 6; float o0 = 0.f, o1 = 0.f;
        const float* vp = cv + ((size_t)sbi * 512 * 8 + h) * 64 + dv;
#pragma unroll 8
        for (int j = 0; j < 512; ++j) { const float v = vp[(size_t)j * 512]; o0 += sc[(2 * ig) * 528 + j] * v; o1 += sc[(2 * ig + 1) * 528 + j] * v; }
#pragma unroll
        for (int j = 0; j < 16; ++j) { const float v = bf2f(proj[(row0 + j) * NPROJ + C_VB + h * 64 + dv]); o0 += sc[(2 * ig) * 528 + 512 + j] * v; o1 += sc[(2 * ig + 1) * 528 + 512 + j] * v; }
        mix[(row0 + 2 * ig) * D + 512 + h * 64 + dv] = f2bf(o0 * ri[2 * ig]);
        mix[(row0 + 2 * ig + 1) * D + 512 + h * 64 + dv] = f2bf(o1 * ri[2 * ig + 1]);
    }
    __syncthreads();
}

constexpr int Q_GDN_P = 128, Q_GDN_S = 64, Q_ATT_S = 128, Q_ATT_P = 1024, Q_TOTAL = Q_GDN_P + Q_GDN_S + Q_ATT_S + Q_ATT_P;
constexpr int L_ITEM = 142336;
__device__ __forceinline__ void phase3(const Params& p, LAS unsigned char* L, int tid_in, int wave, int lane_in) {
    const int tid = opq(tid_in), lane = tid & 63;
    {
        const float* rb = p.in[19] + wave * 320;
        const float qm = wave_max(fabsf(p.in[17][lane])), km = wave_max(fabsf(p.in[18][lane]));
        float bm = -3.0e38f;
        for (int i = lane; i < 320; i += 64) bm = fmaxf(bm, rb[i]);
        bm = wave_max(bm);
        const float bound = 8.f * qm * km + bm;
        LAS float* Tb = (LAS float*)(L + A_TB) + wave * 320;
        for (int i = lane; i < 320; i += 64) Tb[i] = (rb[i] - bound) * LOG2E;
    }
    __syncthreads();
    unsigned* ctr = (unsigned*)(p.ws + WS_CTL);
    volatile LAS int* sitem = (volatile LAS int*)(L + L_ITEM);
    for (;;) {
        if (tid == 0) *sitem = (int)atomicAdd(ctr, 1u);
        __syncthreads();
        int it = *sitem;
        __syncthreads();
        if (it >= Q_TOTAL) break;
        if (it < Q_GDN_P) { const int b = it >> 2, h = it & 3;
            gdn_chunk_item(p, L, b, h, p.out + O_GDN_P + (size_t)it * 16384, tid, wave, lane); continue; }
        it -= Q_GDN_P;
        if (it < Q_GDN_S) { const int b = it >> 2, h = it & 3;
            gdn_item(p, L, MP + b * 16, 16, h, p.in[3] + (size_t)it * 16384, p.in[2] + (size_t)b * 3 * 1536, p.out + O_GDN_S + (size_t)it * 16384, tid, wave, lane); continue; }
        it -= Q_GDN_S;
        if (it < Q_ATT_S) { attn_sample_item(p, L, it >> 3, it & 7, tid, wave, lane); continue; }
        it -= Q_ATT_S;
        attn_prompt_item(p, L, it >> 5, it & 31, wave, lane);
    }
}

#define XB_TMO      128
#define XB_XCNT(j)  (256  + 64 * (j))
#define XB_XSUB(j)  (1280 + 64 * (j))
#define XB_XGEN(j)  (2304 + 64 * (j))
#define XB_TOP      3328
#define XB_TOPGEN   3392
#define XCD_BAR_WORDS 3456
#define XB_SPIN_CAP (1u << 18)

__device__ __forceinline__ unsigned xb_ld(unsigned* p)              { return __hip_atomic_load(p, __ATOMIC_RELAXED, __HIP_MEMORY_SCOPE_AGENT); }
__device__ __forceinline__ unsigned xb_add(unsigned* p, unsigned v) { return __hip_atomic_fetch_add(p, v, __ATOMIC_RELAXED, __HIP_MEMORY_SCOPE_AGENT); }
__device__ __forceinline__ unsigned xb_xcc_id() { return (unsigned)__builtin_amdgcn_s_getreg((3 << 11) | 20) & 0xFu; }
#define XB_SPIN(cond, bar) do { unsigned _sp = 0; while (cond) { __builtin_amdgcn_s_sleep(1); \
    if ((++_sp & 255u) == 0u) { if (xb_ld(&(bar)[XB_TMO])) break; if (_sp > XB_SPIN_CAP) { atomicAdd(&(bar)[XB_TMO], 1u); break; } } } } while (0)

struct XcdBarrier {
    unsigned* bar; unsigned x;
    volatile LAS unsigned* st;
};

__device__ __forceinline__ XcdBarrier xcd_barrier_post(unsigned* bar, volatile LAS unsigned* st) {
    XcdBarrier b; b.bar = bar; b.x = xb_xcc_id(); b.st = st;
    if (threadIdx.x == 0) (void)xb_add(&bar[XB_XCNT(b.x)], 1u);
    return b;
}
__device__ __forceinline__ void xcd_barrier_complete(unsigned* bar, unsigned x, unsigned& nloc, unsigned& nx) {
    const unsigned G = gridDim.x * gridDim.y * gridDim.z;
    unsigned sum, cnt, mine, sp = 0u;
    for (;;) {
        sum = 0u; cnt = 0u; mine = 0u;
#pragma unroll
        for (unsigned j = 0; j < 16; ++j) { const unsigned c = xb_ld(&bar[XB_XCNT(j)]); sum += c; cnt += (c > 0u) ? 1u : 0u; mine = (j == x) ? c : mine; }
        if (sum == G) break;
        __builtin_amdgcn_s_sleep(1);
        if ((++sp & 255u) == 0u) { if (xb_ld(&bar[XB_TMO])) break; if (sp > XB_SPIN_CAP) { atomicAdd(&bar[XB_TMO], 1u); break; } }
    }
    nloc = mine > 0u ? mine : 1u; nx = cnt > 0u ? cnt : 1u;
}

__device__ __forceinline__ void xcd_barrier(const XcdBarrier& b) {
    asm volatile("s_waitcnt vmcnt(0)" ::: "memory");
    __syncthreads();
    if (threadIdx.x == 0) {
        unsigned* bar = b.bar;
        __builtin_amdgcn_s_waitcnt(0);
        unsigned nloc = b.st[0], nx = b.st[1];
        if (nloc == 0u) { xcd_barrier_complete(bar, b.x, nloc, nx); b.st[0] = nloc; b.st[1] = nx; }
        const unsigned old = xb_add(&bar[XB_XSUB(b.x)], 1u);
        const unsigned gen = old / nloc;
        if (old + 1u == (gen + 1u) * nloc) {
            __builtin_amdgcn_fence(__ATOMIC_RELEASE, "agent");
            asm volatile("s_waitcnt vmcnt(0)" ::: "memory");
            const unsigned og = xb_add(&bar[XB_TOP], 1u);
            const unsigned tg = og / nx;
            if (og + 1u == (tg + 1u) * nx) xb_add(&bar[XB_TOPGEN], 1u);
            else XB_SPIN(xb_ld(&bar[XB_TOPGEN]) == tg, bar);
            __builtin_amdgcn_fence(__ATOMIC_ACQUIRE, "agent");
            xb_add(&bar[XB_XGEN(b.x)], 1u);
            asm volatile("s_waitcnt vmcnt(0)" ::: "memory");
        } else {
            XB_SPIN(xb_ld(&bar[XB_XGEN(b.x)]) == gen, bar);
            __builtin_amdgcn_fence(__ATOMIC_ACQUIRE, "agent");
            asm volatile("s_waitcnt vmcnt(0)" ::: "memory");
        }
    }
    __syncthreads();
}

__global__ void __launch_bounds__(NTHREADS, 2) fwd_megakernel(Params p) {
    extern __shared__ __attribute__((aligned(16))) unsigned char lds_raw[];
    LAS unsigned char* L = (LAS unsigned char*)lds_raw;
    cg::grid_group grid = cg::this_grid();
    const int tid = threadIdx.x, lane = tid & 63, wave = __builtin_amdgcn_readfirstlane(tid >> 6);
    const int G = gridDim.x;
    volatile LAS unsigned* xbst = (volatile LAS unsigned*)(L + LDS_XB);
    if (tid < 2) xbst[tid] = 0u;
    __syncthreads();
    const XcdBarrier xbar = xcd_barrier_post((unsigned*)(p.ws + WS_CTL) + CW_BAR, xbst);
    const bf16_t* H = (const bf16_t*)(p.ws + WS_H);
    const float* MOD = (const float*)(p.ws + WS_MOD);

    grid.sync();
    phase0(p, L, tid, wave, lane);
    xcd_barrier(xbar);
    prepass<true>(p, L, tid, wave, lane);
    xcd_barrier(xbar);
    {
        pg8::Gemm g{H, (const bf16_t*)(p.ws + WS_WIN), M, NPROJ, D}; pg8::StaticOrder S; S.init(M, NPROJ, G, (int)blockIdx.x);
        EpiIn E{(bf16_t*)(p.ws + WS_PROJ), (bf16_t*)(p.ws + WS_VT), p.in[17], p.in[18], p.out, L + 131072};
        pg8::gemm_phase<EpiIn, pg8::StaticOrder, true, true>(L, g, S, E);
    }
    xcd_barrier(xbar);
    phase3(p, L, tid, wave, lane);
    xcd_barrier(xbar);
    {
        pg8::Gemm g{(const bf16_t*)(p.ws + WS_MIX), (const bf16_t*)(p.ws + WS_WOUT), M, D, D}; pg8::StaticOrder S; S.init(M, D, G, (int)blockIdx.x);
        EpiRes<false> E{p.in[0], p.in[1], MOD, 2048, p.out + O_Y, (bf16_t*)(p.ws + WS_X1B)};
        pg8::gemm_phase<EpiRes<false>, pg8::StaticOrder, true, true>(L, g, S, E);
    }
    xcd_barrier(xbar);
    prepass<false>(p, L, tid, wave, lane);
    xcd_barrier(xbar);
    {
        pg8::Gemm g{H, (const bf16_t*)(p.ws + WS_WUP), M, DFF, D}; pg8::StaticOrder S; S.init(M, DFF, G, (int)blockIdx.x);
        EpiUp E{(bf16_t*)(p.ws + WS_PROJ)};
        pg8::gemm_phase<EpiUp, pg8::StaticOrder, true, true>(L, g, S, E);
    }
    xcd_barrier(xbar);
    {
        pg8::Gemm g{(const bf16_t*)(p.ws + WS_PROJ), (const bf16_t*)(p.ws + WS_WDN), M, D, DFF}; pg8::SplitTailOrder S; S.init(MP, D, G, (int)blockIdx.x);
        EpiRes<true> E{nullptr, nullptr, MOD, 5120, p.out + O_Y, (bf16_t*)(p.ws + WS_X1B)};
        pg8::gemm_phase<EpiRes<true>, pg8::SplitTailOrder, true, true>(L, g, S, E);
    }
}

extern "C" void kernel_launch(void* const* d_in, const int* in_sizes, int n_in, void* d_out, int out_size, void* d_ws, size_t ws_size, hipStream_t stream) {
    static int grid = 0;
    if (grid == 0) {
        if (n_in != 23 || ws_size < WS_END) { fprintf(stderr, "kernel_launch: unexpected n_in %d / ws_size %zu\n", n_in, ws_size); grid = -1; return; }
        int dev = 0, cus = 0, per_cu = 0;
        hipGetDevice(&dev);
        hipDeviceGetAttribute(&cus, hipDeviceAttributeMultiprocessorCount, dev);
        if (hipFuncSetAttribute((const void*)fwd_megakernel, hipFuncAttributeMaxDynamicSharedMemorySize, LDS_BYTES) != hipSuccess) { fprintf(stderr, "kernel_launch: hipFuncSetAttribute failed\n"); grid = -1; return; }
        if (hipOccupancyMaxActiveBlocksPerMultiprocessor(&per_cu, (const void*)fwd_megakernel, NTHREADS, LDS_BYTES) != hipSuccess || per_cu < 1) { fprintf(stderr, "kernel_launch: occupancy query failed (%d)\n", per_cu); per_cu = 1; (void)hipGetLastError(); }
        grid = cus * per_cu;
    }
    if (grid < 0) return;
    (void)hipMemsetAsync((char*)d_ws + WS_CTL, 0, 65536, stream);
    Params p{};
    for (int i = 0; i < 23; ++i) p.in[i] = (const float*)d_in[i];
    p.out = (float*)d_out; p.ws = (unsigned char*)d_ws;
    void* args[] = {&p};
    hipError_t e = hipLaunchCooperativeKernel((const void*)fwd_megakernel, dim3(grid), dim3(NTHREADS), args, LDS_BYTES, stream);
    if (e != hipSuccess) fprintf(stderr, "kernel_launch: cooperative launch failed: %s (grid %d)\n", hipGetErrorString(e), grid);
}
```

```cpp
#include <hip/hip_runtime.h>
#include <hip/hip_cooperative_groups.h>
#include <cstdio>
#include <cstdint>
#include <utility>
namespace cg = cooperative_groups;
namespace pg8 {
#define PG8_LAS __attribute__((address_space(3)))
typedef unsigned short bf16_t;
typedef short bf16x8 __attribute__((ext_vector_type(8)));
typedef float f32x4 __attribute__((ext_vector_type(4)));
typedef unsigned u32x4 __attribute__((ext_vector_type(4)));
constexpr int BM = 256, BK = 64, HALF = 128, HTB = HALF * BK * 2  , STAGE_BYTES = 8 * HTB, NXCD = 8, WGM = 8;

__host__ __device__ __forceinline__ int lds_byte(int r, int c) { const int st = (r >> 4) * 2 + (c >> 5), rr = r & 15, cc = c & 31, ob = rr * 64 + cc * 2; return st * 1024 + (ob ^ (((ob >> 9) & 1) << 5)); }
__host__ __device__ __forceinline__ void stage_rc(int b, int& R, int& C) { const int st = b / 1024, sb = b % 1024, swz = sb ^ (((sb >> 9) & 1) << 5); R = (st >> 1) * 16 + swz / 64; C = (st & 1) * 32 + (swz % 64) / 2; }
__host__ __device__ __forceinline__ int perm32(int rho) { const int n = rho >> 4, i = rho & 15; return 8 * (i >> 2) + 4 * n + (i & 3); }

struct Unit { int pm, pn, kq; };
struct Gemm { const bf16_t* A; const bf16_t* Bt; int M, N, K; };

struct StaticOrder {
    int nM, nN, nwg, G, c;
    __host__ __device__ void init(int M, int N, int G_, int c_) { nM = M / BM; nN = N / BM; nwg = nM * nN; G = G_; c = c_; }
    __host__ __device__ bool next(int i, Unit& u) const {
        const long L = (long)i * G + c; if (L >= nwg) return false;
        int wgid = (int)L; { const int q = nwg / NXCD, r = nwg % NXCD, xcd = wgid % NXCD, off = wgid / NXCD; wgid = (xcd < r ? xcd * (q + 1) : r * (q + 1) + (xcd - r) * q) + off; }
        const int nig = WGM * nN, gid = wgid / nig, fm = gid * WGM, gsz = (nM - fm) < WGM ? (nM - fm) : WGM;
        u.pm = fm + ((wgid % nig) % gsz); u.pn = (wgid % nig) / gsz; u.kq = -1; return true;
    }
    __device__ __forceinline__ void a_ready(const Unit&) const {}
    __device__ __forceinline__ void done(const Unit&) const {}
};

struct SplitTailOrder {
    StaticOrder base; int nMp, nN;
    __host__ __device__ void init(int Mp, int N, int G_, int c_) { base.init(Mp, N, G_, c_); nMp = Mp / BM; nN = N / BM; }
    __host__ __device__ bool next(int i, Unit& u) const {
        const long L = (long)i * base.G + base.c;
        if (L < base.nwg) return base.next(i, u);
        const int s = (int)(L - base.nwg); if (s >= 8 * nN) return false;
        u.pm = nMp; u.pn = s % nN; u.kq = s / nN; return true;
    }
    __device__ __forceinline__ void a_ready(const Unit&) const {}
    __device__ __forceinline__ void done(const Unit&) const {}
};
template <class Epi, class Sched, bool ALIGN_EPI = false, bool SP2 = false>
__device__ __forceinline__ void gemm_phase(PG8_LAS unsigned char* lds, const Gemm g, const Sched& S, const Epi& E) {
    int tid_ = threadIdx.x; asm volatile("" : "+v"(tid_));
    const int tid = tid_, wid = __builtin_amdgcn_readfirstlane(tid >> 6), lane = tid & 63, wr = wid >> 2, wc = wid & 3, fr = lane & 15, fq = lane >> 4;
    const int K = g.K, nt = K / BK;
    unsigned voffA[2], voffB[2];
#pragma unroll
    for (int i = 0; i < 2; ++i) { int R, C; stage_rc(tid * 16 + i * 8192, R, C); const int Rb = Epi::PERM ? ((R & ~31) + perm32(R & 31)) : R;
        voffA[i] = (unsigned)(R * K + C) * 2u; voffB[i] = (unsigned)(Rb * K + C) * 2u; }
    const size_t kstep = (size_t)(BK * 2);
    const size_t hstep = (size_t)HALF * K * 2;
    const size_t tstep = 2 * hstep;
    const unsigned ldsw = (unsigned)wid * 1024u;
    const int aoff = lds_byte(wr * 64 + fr, fq * 8), boff = lds_byte(wc * 32 + fr, fq * 8);
#define PG8_SA(b, h) (((b) * 2 + (h)) * HTB)
#define PG8_SB(b, h) ((4 + (b) * 2 + (h)) * HTB)
#define PG8_STAGE(bufoff, gbase, voff) do { _Pragma("unroll") for (int _i = 0; _i < 2; ++_i) \
        __builtin_amdgcn_global_load_lds((const unsigned*)((const char*)(gbase) + (voff)[_i]), (PG8_LAS unsigned*)(lds + (bufoff) + ldsw + _i * 8192), 16, 0, 0); } while (0)
#define PG8_LDA(dst, b, h) do { _Pragma("unroll") for (int m = 0; m < 4; ++m) _Pragma("unroll") for (int k = 0; k < 2; ++k) dst[m][k] = *(const PG8_LAS bf16x8*)(lds + PG8_SA(b, h) + aoff + m * 2048 + k * 1024); } while (0)
#define PG8_LDB(dst, b, h) do { _Pragma("unroll") for (int n = 0; n < 2; ++n) _Pragma("unroll") for (int k = 0; k < 2; ++k) dst[n][k] = *(const PG8_LAS bf16x8*)(lds + PG8_SB(b, h) + boff + n * 2048 + k * 1024); } while (0)
#define PG8_MMA(ai, bj, At, Bt) do { __builtin_amdgcn_s_setprio(1); _Pragma("unroll") for (int m = 0; m < 4; ++m) _Pragma("unroll") for (int n = 0; n < 2; ++n) _Pragma("unroll") for (int k = 0; k < 2; ++k) \
        acc[ai][bj][m][n] = __builtin_amdgcn_mfma_f32_16x16x32_bf16(Bt[n][k], At[m][k], acc[ai][bj][m][n], 0, 0, 0); __builtin_amdgcn_s_setprio(0); } while (0)
#define PG8_WAIT_V(n) asm volatile("s_waitcnt vmcnt(" #n ")" ::: "memory")
#define PG8_WAIT_L(n) asm volatile("s_waitcnt lgkmcnt(" #n ")" ::: "memory")
#define PG8_BAR __builtin_amdgcn_s_barrier()
#define PG8_SCHED __builtin_amdgcn_sched_barrier(0)
    Unit cur, nxt; int ui = 0;
    if (!S.next(0, cur)) return;
    f32x4 acc[2][2][4][2];
#pragma unroll
    for (int a = 0; a < 2; ++a)
#pragma unroll
        for (int b = 0; b < 2; ++b)
#pragma unroll
            for (int m = 0; m < 4; ++m)
#pragma unroll
                for (int n = 0; n < 2; ++n) acc[a][b][m][n] = (f32x4){0.f, 0.f, 0.f, 0.f};
    bf16x8 At[4][2], B0[2][2], B1[2][2];
    const size_t qstep = (size_t)(K / 8) * 2;
    const char* cA = (const char*)g.A + (size_t)cur.pm * tstep + (cur.kq > 0 ? cur.kq * qstep : 0); const char* cB = (const char*)g.Bt + (size_t)cur.pn * tstep + (cur.kq > 0 ? cur.kq * qstep : 0);
    int cnt = cur.kq < 0 ? nt : nt / 8;
    S.a_ready(cur);
    if constexpr (SP2) {
        PG8_STAGE(PG8_SB(0, 0), cB, voffB); PG8_STAGE(PG8_SB(0, 1), cB + hstep, voffB); PG8_STAGE(PG8_SA(0, 0), cA, voffA); PG8_STAGE(PG8_SA(0, 1), cA + hstep, voffA);
        if (wr == 1) PG8_BAR;
        PG8_WAIT_V(2); PG8_BAR;
        PG8_STAGE(PG8_SB(1, 0), cB + kstep, voffB); PG8_STAGE(PG8_SA(1, 0), cA + kstep, voffA); PG8_STAGE(PG8_SB(1, 1), cB + hstep + kstep, voffB);
        PG8_WAIT_V(6); PG8_BAR;
    } else {
        PG8_STAGE(PG8_SB(0, 0), cB, voffB); PG8_STAGE(PG8_SA(0, 0), cA, voffA); PG8_STAGE(PG8_SB(0, 1), cB + hstep, voffB); PG8_STAGE(PG8_SA(0, 1), cA + hstep, voffA);
        if (wr == 1) PG8_BAR;
        PG8_WAIT_V(4); PG8_BAR;
        PG8_STAGE(PG8_SB(1, 0), cB + kstep, voffB); PG8_STAGE(PG8_SA(1, 0), cA + kstep, voffA); PG8_STAGE(PG8_SB(1, 1), cB + hstep + kstep, voffB);
        PG8_WAIT_V(6); PG8_BAR;
    }
    for (;;) {
        const bool has_next = S.next(ui + 1, nxt);
        const size_t nq = (has_next && nxt.kq > 0) ? nxt.kq * qstep : 0;
        const char* nA = has_next ? (const char*)g.A + (size_t)nxt.pm * tstep + nq : cA; const char* nB = has_next ? (const char*)g.Bt + (size_t)nxt.pn * tstep + nq : cB;
        for (int t = 0; t < cnt; t += 2) {
            const bool last = (t == cnt - 2);
            const char* a1 = cA + (size_t)(t + 1) * kstep;
            const char* a2 = last ? nA : cA + (size_t)(t + 2) * kstep; const char* b2 = last ? nB : cB + (size_t)(t + 2) * kstep;
            const char* a3 = a2 + kstep; const char* b3 = b2 + kstep;
            if (last && has_next) S.a_ready(nxt);
            if constexpr (SP2) {
            PG8_LDB(B0, 0, 0); PG8_LDB(B1, 0, 1); PG8_SCHED; PG8_LDA(At, 0, 0); PG8_STAGE(PG8_SA(1, 1), a1 + hstep, voffA);
            PG8_WAIT_V(8); PG8_WAIT_L(0); PG8_BAR; PG8_MMA(0, 0, At, B0); PG8_MMA(0, 1, At, B1); PG8_BAR; PG8_SCHED;
            PG8_LDA(At, 0, 1); PG8_STAGE(PG8_SB(0, 0), b2, voffB); PG8_STAGE(PG8_SB(0, 1), b2 + hstep, voffB); PG8_STAGE(PG8_SA(0, 0), a2, voffA);
            PG8_WAIT_V(8); PG8_WAIT_L(0); PG8_BAR; PG8_MMA(1, 0, At, B0); PG8_MMA(1, 1, At, B1); PG8_BAR; PG8_SCHED;
            PG8_LDB(B0, 1, 0); PG8_LDB(B1, 1, 1); PG8_SCHED; PG8_LDA(At, 1, 0); PG8_STAGE(PG8_SA(0, 1), a2 + hstep, voffA);
            PG8_WAIT_V(8); PG8_WAIT_L(0); PG8_BAR; PG8_MMA(0, 0, At, B0); PG8_MMA(0, 1, At, B1); PG8_BAR; PG8_SCHED;
            PG8_LDA(At, 1, 1); PG8_STAGE(PG8_SB(1, 0), b3, voffB); PG8_STAGE(PG8_SB(1, 1), b3 + hstep, voffB); PG8_STAGE(PG8_SA(1, 0), a3, voffA);
            PG8_WAIT_V(8); PG8_WAIT_L(0); PG8_BAR; PG8_MMA(1, 0, At, B0); PG8_MMA(1, 1, At, B1); PG8_BAR; PG8_SCHED;
            } else {
            PG8_LDB(B0, 0, 0); PG8_SCHED; PG8_LDA(At, 0, 0); PG8_STAGE(PG8_SA(1, 1), a1 + hstep, voffA);
            PG8_WAIT_L(8); PG8_BAR; PG8_WAIT_L(0); PG8_MMA(0, 0, At, B0); PG8_BAR; PG8_SCHED;
            PG8_LDB(B1, 0, 1); PG8_STAGE(PG8_SB(0, 0), b2, voffB);
            PG8_BAR; PG8_WAIT_L(0); PG8_MMA(0, 1, At, B1); PG8_BAR;
            PG8_LDA(At, 0, 1); PG8_STAGE(PG8_SA(0, 0), a2, voffA);
            PG8_BAR; PG8_WAIT_L(0); PG8_MMA(1, 0, At, B0); PG8_BAR; PG8_SCHED;
            PG8_STAGE(PG8_SB(0, 1), b2 + hstep, voffB);
            PG8_WAIT_V(6); PG8_BAR; PG8_MMA(1, 1, At, B1); PG8_BAR;
            PG8_LDB(B0, 1, 0); PG8_SCHED; PG8_LDA(At, 1, 0); PG8_STAGE(PG8_SA(0, 1), a2 + hstep, voffA);
            PG8_WAIT_L(8); PG8_BAR; PG8_WAIT_L(0); PG8_MMA(0, 0, At, B0); PG8_BAR; PG8_SCHED;
            PG8_LDB(B1, 1, 1); PG8_STAGE(PG8_SB(1, 0), b3, voffB);
            PG8_BAR; PG8_WAIT_L(0); PG8_MMA(0, 1, At, B1); PG8_BAR;
            PG8_LDA(At, 1, 1); PG8_STAGE(PG8_SA(1, 0), a3, voffA);
            PG8_BAR; PG8_WAIT_L(0); PG8_MMA(1, 0, At, B0); PG8_BAR; PG8_SCHED;
            PG8_STAGE(PG8_SB(1, 1), b3 + hstep, voffB);
            PG8_WAIT_V(6); PG8_BAR; PG8_MMA(1, 1, At, B1); PG8_BAR;
            }
        }
        if constexpr (ALIGN_EPI) { if (wr == 0) PG8_BAR; }
        if constexpr (!Epi::AFTER_DRAIN) { E(acc, cur, wr, wc, fr, fq); S.done(cur); }
        if (!has_next) break;
#pragma unroll
        for (int a = 0; a < 2; ++a)
#pragma unroll
            for (int b = 0; b < 2; ++b)
#pragma unroll
                for (int m = 0; m < 4; ++m)
#pragma unroll
                    for (int n = 0; n < 2; ++n) acc[a][b][m][n] = (f32x4){0.f, 0.f, 0.f, 0.f};
        cur = nxt; cA = nA; cB = nB; ++ui; cnt = cur.kq < 0 ? nt : nt / 8;
        if constexpr (ALIGN_EPI) { if (wr == 1) PG8_BAR; }
    }
    PG8_WAIT_V(0);
    if constexpr (!ALIGN_EPI) { if (wr == 0) PG8_BAR; }
    PG8_BAR;
    if constexpr (Epi::AFTER_DRAIN) { E.fused(acc, cur, wr, wc, fr, fq, lds, wid, lane); S.done(cur); }
#undef PG8_SA
#undef PG8_SB
#undef PG8_STAGE
#undef PG8_LDA
#undef PG8_LDB
#undef PG8_MMA
#undef PG8_WAIT_V
#undef PG8_WAIT_L
#undef PG8_BAR
#undef PG8_SCHED
}
}

#define LAS __attribute__((address_space(3)))
typedef unsigned short bf16_t;
typedef float f32x4 __attribute__((ext_vector_type(4)));
typedef float f32x2 __attribute__((ext_vector_type(2)));
typedef short bf16x8 __attribute__((ext_vector_type(8)));
typedef unsigned u32x4 __attribute__((ext_vector_type(4)));
typedef unsigned u32x2 __attribute__((ext_vector_type(2)));

constexpr int NTHREADS = 512;
constexpr int D = 1024, TP = 2048, MP = 65536, MS = 256, M = MP + MS, NPROJ = 3584, DFF = 4096, WIN_LD = 3592;
constexpr float EPS = 1e-6f, LOG2E = 1.4426950408889634f;
constexpr int C_QA = 0, C_KA = 512, C_VA = 1024, C_GA = 1536, C_QB = 2048, C_KB = 2560, C_VB = 3072;
constexpr size_t O_Y = 0, O_CONV_P = 67371008, O_GDN_P = 67518464, O_KB_P = 69615616, O_VB_P = 78004224,
                 O_CONV_S = 86392832, O_GDN_S = 86466560, O_KN_S = 87515136, O_VN_S = 87646208;
constexpr size_t MiB = 1u << 20;
constexpr size_t WS_CTL = 0, WS_WIN = 1 * MiB, WS_WOUT = 8 * MiB, WS_WUP = 10 * MiB, WS_WDN = 18 * MiB, WS_MOD = 26 * MiB, WS_BA = 28 * MiB,
                 WS_H = 32 * MiB, WS_MIX = 161 * MiB, WS_VT = 290 * MiB, WS_PROJ = 354 * MiB  , WS_X1B = 880 * MiB  , WS_END = 1010 * MiB;
constexpr int LDS_XB = 147456;
constexpr int LDS_BYTES = 147456 + 256;
constexpr int CW_BAR = 4096;

struct Params { const float* in[23]; float* out; unsigned char* ws; };

__device__ __forceinline__ unsigned cvt_pk_bf16(float lo, float hi) { unsigned r; asm volatile("v_cvt_pk_bf16_f32 %0, %1, %2" : "=v"(r) : "v"(lo), "v"(hi)); return r; }
__device__ __forceinline__ bf16_t f2bf(float f) { return (bf16_t)(cvt_pk_bf16(f, 0.f) & 0xffffu); }
__device__ __forceinline__ float bf2f(bf16_t h) { return __uint_as_float(((unsigned)h) << 16); }
__device__ __forceinline__ float wave_sum(float v) {
#pragma unroll
    for (int o = 1; o < 64; o <<= 1) v += __shfl_xor(v, o);
    return v;
}
__device__ __forceinline__ float wave_max(float v) {
#pragma unroll
    for (int o = 1; o < 64; o <<= 1) v = fmaxf(v, __shfl_xor(v, o));
    return v;
}
template <int CTRL> __device__ __forceinline__ float dpp_f(float v) { return __int_as_float(__builtin_amdgcn_update_dpp(0, __float_as_int(v), CTRL, 0xf, 0xf, true)); }
__device__ __forceinline__ float wave_sum_u(float v) {
    v += dpp_f<0x111>(v); v += dpp_f<0x112>(v); v += dpp_f<0x114>(v); v += dpp_f<0x118>(v);
    const int iv = __float_as_int(v);
    return (__int_as_float(__builtin_amdgcn_readlane(iv, 15)) + __int_as_float(__builtin_amdgcn_readlane(iv, 31))) + (__int_as_float(__builtin_amdgcn_readlane(iv, 47)) + __int_as_float(__builtin_amdgcn_readlane(iv, 63)));
}
template <int N> __device__ __forceinline__ void fmac_bc(float& s, float mv, float xj) { asm("v_fmac_f32_dpp %0, %1, %2 row_newbcast:%3 row_mask:0xf bank_mask:0xf bound_ctrl:1" : "+v"(s) : "v"(mv), "v"(xj), "n"(N)); }
__device__ __forceinline__ int opq(int v) { asm volatile("" : "+v"(v)); return v; }
__device__ __forceinline__ int row_batch(int row) { return row < MP ? (row >> 11) : 32 + ((row - MP) >> 4); }
__device__ __forceinline__ float silu_f(float x) { return x * __builtin_amdgcn_rcpf(1.f + __builtin_amdgcn_exp2f(-LOG2E * x)); }
__device__ __forceinline__ float sigmoid_f(float x) { return __builtin_amdgcn_rcpf(1.f + __builtin_amdgcn_exp2f(-LOG2E * x)); }
__device__ __forceinline__ int perm_pos(int c) { return ((c >> 5) & 1) * 128 + (c >> 6) * 32 + ((c >> 2) & 1) * 16 + ((c >> 3) & 3) * 4 + (c & 3); }

__device__ __forceinline__ void transpose_item(const float* W, int ldw, int K, int N, bool skip8, bf16_t* WT, LAS float* scr, int item, int lane) {
    const int nblk = N / 64, kb = item / nblk, nb = item % nblk, k0 = 64 * kb, n0 = 64 * nb;
    const int soff = (skip8 && n0 >= 2048) ? 8 : 0;
#pragma unroll 8
    for (int i = 0; i < 64; ++i) scr[i * 65 + lane] = W[(size_t)(k0 + i) * ldw + soff + n0 + lane];
    asm volatile("s_waitcnt lgkmcnt(0)" ::: "memory");
    const int c = lane & 7;
#pragma unroll
    for (int j = 0; j < 8; ++j) { const int n = (lane >> 3) + 8 * j; const LAS float* s = scr + (8 * c) * 65 + n;
        u32x4 o; o.x = cvt_pk_bf16(s[0 * 65], s[1 * 65]); o.y = cvt_pk_bf16(s[2 * 65], s[3 * 65]); o.z = cvt_pk_bf16(s[4 * 65], s[5 * 65]); o.w = cvt_pk_bf16(s[6 * 65], s[7 * 65]);
        const int col = n0 + n, drow = (col & ~255) + perm_pos(col & 255);
        *(u32x4*)(WT + (size_t)drow * K + k0 + 8 * c) = o; }
    asm volatile("s_waitcnt lgkmcnt(0)" ::: "memory");
}

template <int... E> __device__ __forceinline__ void mod_fma16(float& acc, float scv, const float (&w)[16], std::integer_sequence<int, E...>) { (fmac_bc<E>(acc, scv, w[E]), ...); }
__device__ __forceinline__ void mod_item(const Params& p, LAS unsigned char* L, int jb, int tid) {
    LAS float* sc = (LAS float*)L;
    LAS float* red = (LAS float*)L;
    const int jj = tid & 31, kg = tid >> 5, j0 = jb * 32;
    const float* cp = p.in[6]; const float* cs = p.in[7]; const float* wm = p.in[8]; const float* bm = p.in[9];
    float* MOD = (float*)(p.ws + WS_MOD);
    float acc[48];
#pragma unroll
    for (int b = 0; b < 48; ++b) acc[b] = 0.f;
    for (int kc = 0; kc < 4; ++kc) {
        __syncthreads();
        for (int i = tid; i < 48 * 256; i += NTHREADS) { const int b = i >> 8, kk = i & 255; const float c = (b < 32) ? cp[b * 1024 + kc * 256 + kk] : cs[(b - 32) * 1024 + kc * 256 + kk]; sc[i] = silu_f(c); }
        __syncthreads();
        {
            float w[16];
#pragma unroll
            for (int e = 0; e < 16; ++e) w[e] = wm[(size_t)(kc * 256 + 16 * kg + e) * 6144 + j0 + jj];
#pragma unroll
            for (int b = 0; b < 48; ++b) { const float scv = sc[b * 256 + 16 * kg + (tid & 15)]; mod_fma16(acc[b], scv, w, std::make_integer_sequence<int, 16>{}); }
        }
    }
    __syncthreads();
#pragma unroll
    for (int b = 0; b < 48; ++b) red[(kg * 48 + b) * 32 + jj] = acc[b];
    __syncthreads();
    for (int i = tid; i < 48 * 32; i += NTHREADS) { const int b = i >> 5, j = i & 31; float s = 0.f;
#pragma unroll
        for (int k = 0; k < 16; ++k) s += red[(k * 48 + b) * 32 + j];
        MOD[b * 6144 + j0 + j] = s + bm[j0 + j]; }
    __syncthreads();
}

__device__ __forceinline__ void phase0(const Params& p, LAS unsigned char* L, int tid, int wave, int lane) {
    constexpr int I_IN = 16 * 56, I_OUT = 16 * 16, I_UP = 16 * 64, I_DN = 64 * 16, NIT = I_IN + I_OUT + I_UP + I_DN, NGRP = NIT / 8, NMOD = 192;
    unsigned* ctr = (unsigned*)(p.ws + WS_CTL) + 1;
    volatile LAS int* sitem = (volatile LAS int*)(L + 142336);
    LAS float* scr = (LAS float*)(L + wave * 16640);
    for (;;) {
        if (tid == 0) *sitem = (int)atomicAdd(ctr, 1u);
        __syncthreads();
        const int it = *sitem;
        __syncthreads();
        if (it >= NMOD + NGRP) break;
        if (it < NMOD) { mod_item(p, L, it, tid); continue; }
        int r = (it - NMOD) * 8 + wave;
        if (r < I_IN) { transpose_item(p.in[12], WIN_LD, D, NPROJ, true, (bf16_t*)(p.ws + WS_WIN), scr, r, lane); continue; } r -= I_IN;
        if (r < I_OUT) { transpose_item(p.in[20], D, D, D, false, (bf16_t*)(p.ws + WS_WOUT), scr, r, lane); continue; } r -= I_OUT;
        if (r < I_UP) { transpose_item(p.in[21], DFF, D, DFF, false, (bf16_t*)(p.ws + WS_WUP), scr, r, lane); continue; } r -= I_UP;
        transpose_item(p.in[22], D, DFF, D, false, (bf16_t*)(p.ws + WS_WDN), scr, r, lane);
    }
}

#define PP_EO(j) (8 * lane + 512 * ((j) >> 1) + 4 * ((j) & 1))
template <bool FIRST>
__device__ __forceinline__ void prepass(const Params& p, LAS unsigned char* L, int tid, int wave, int lane) {
    const float* MOD = (const float*)(p.ws + WS_MOD);
    bf16_t* H = (bf16_t*)(p.ws + WS_H);
    float* BA = (float*)(p.ws + WS_BA);
    LAS float* wba = (LAS float*)L;
    if (FIRST) {
        const float* win = p.in[12];
        for (int i = tid; i < 8192; i += NTHREADS) { const int k = i >> 3, c = i & 7; wba[c * 1024 + k] = win[(size_t)k * WIN_LD + 2048 + c]; }
        __syncthreads();
    }
    const float* gn = FIRST ? p.in[10] : p.in[11];
    const int shoff = FIRST ? 0 : 3072, scoff = FIRST ? 1024 : 4096;
    f32x4 g[4];
#pragma unroll
    for (int j = 0; j < 4; ++j) g[j] = *(const f32x4*)(gn + PP_EO(j));
    const int gw = blockIdx.x * 8 + wave, NGW = gridDim.x * 8;
    const bf16_t* X1B = (const bf16_t*)(p.ws + WS_X1B);
    auto ldrow = [&](int row, f32x4 (&dst)[4]) {
#pragma unroll
        for (int gr = 0; gr < 2; ++gr) {
            if (FIRST) { const float* xr = (row < MP ? p.in[0] + (size_t)row * D : p.in[1] + (size_t)(row - MP) * D) + 8 * lane + 512 * gr; dst[2 * gr] = *(const f32x4*)xr; dst[2 * gr + 1] = *(const f32x4*)(xr + 4); }
            else { const u32x4 w = *(const u32x4*)(X1B + (size_t)row * D + 8 * lane + 512 * gr);
                dst[2 * gr] = (f32x4){__uint_as_float(w.x << 16), __uint_as_float(w.x & 0xffff0000u), __uint_as_float(w.y << 16), __uint_as_float(w.y & 0xffff0000u)};
                dst[2 * gr + 1] = (f32x4){__uint_as_float(w.z << 16), __uint_as_float(w.z & 0xffff0000u), __uint_as_float(w.w << 16), __uint_as_float(w.w & 0xffff0000u)}; }
        } };
    f32x4 vn[4];
    if (gw < M) ldrow(gw, vn);
    for (int row = gw; row < M; row += NGW) {
        const int b = row_batch(row);
        f32x4 v[4]; float ss = 0.f;
#pragma unroll
        for (int j = 0; j < 4; ++j) { v[j] = vn[j]; ss += (v[j].x * v[j].x + v[j].y * v[j].y) + (v[j].z * v[j].z + v[j].w * v[j].w); }
        if (row + NGW < M) ldrow(row + NGW, vn);
        const float rstd = rsqrtf(wave_sum_u(ss) * (1.f / D) + EPS);
        const float* mb = MOD + (size_t)b * 6144;
#pragma unroll
        for (int j = 0; j < 4; ++j) { const f32x4 sc = *(const f32x4*)(mb + scoff + PP_EO(j)), sh = *(const f32x4*)(mb + shoff + PP_EO(j));
            v[j] = v[j] * rstd * g[j] * (sc + 1.f) + sh; }
#pragma unroll
        for (int gr = 0; gr < 2; ++gr) { u32x4 w; w.x = cvt_pk_bf16(v[2 * gr].x, v[2 * gr].y); w.y = cvt_pk_bf16(v[2 * gr].z, v[2 * gr].w); w.z = cvt_pk_bf16(v[2 * gr + 1].x, v[2 * gr + 1].y); w.w = cvt_pk_bf16(v[2 * gr + 1].z, v[2 * gr + 1].w);
            *(u32x4*)(H + (size_t)row * D + 8 * lane + 512 * gr) = w; }
        if (FIRST) {
            float mine = 0.f;
#pragma unroll
            for (int c = 0; c < 8; ++c) { float s = 0.f;
#pragma unroll
                for (int j = 0; j < 4; ++j) { const f32x4 w = *(const LAS f32x4*)(wba + c * 1024 + PP_EO(j)); s += (v[j].x * w.x + v[j].y * w.y) + (v[j].z * w.z + v[j].w * w.w); }
                s = wave_sum_u(s); if (lane == c) mine = s; }
            if (lane < 8) BA[(size_t)row * 8 + lane] = mine;
        }
    }
}

#undef PP_EO
struct EpiIn {
    static constexpr bool PERM = false, AFTER_DRAIN = false;
    bf16_t* proj; bf16_t* vt; const float* qn_g; const float* kn_g; float* out; LAS unsigned char* xl;
    __device__ __forceinline__ void operator()(const f32x4 (&acc)[2][2][4][2], const pg8::Unit& u, int wr, int wc, int fr, int fq) const {
        const int grp = u.pn >> 1;
        const int col0 = u.pn * 256 + wc * 64 + fq * 8;
        const bool samp = (u.pm == 256);
        const bool nrm = (grp == 4 || grp == 5);
        f32x4 gq[2][2];
        if (nrm) { const float* gp = (grp == 4) ? qn_g : kn_g; const float scl = (grp == 4) ? 0.125f * LOG2E : 1.f;
#pragma unroll
            for (int bj = 0; bj < 2; ++bj)
#pragma unroll
                for (int n = 0; n < 2; ++n) gq[bj][n] = *(const f32x4*)(gp + bj * 32 + fq * 8 + n * 4) * scl; }
#pragma unroll
        for (int ai = 0; ai < 2; ++ai)
#pragma unroll
            for (int m = 0; m < 4; ++m) {
                const int row = u.pm * 256 + ai * 128 + wr * 64 + m * 16 + fr;
                f32x4 v[2][2];
#pragma unroll
                for (int bj = 0; bj < 2; ++bj)
#pragma unroll
                    for (int n = 0; n < 2; ++n) v[bj][n] = acc[ai][bj][m][n];
                if (nrm) {
                    float ss = 0.f;
#pragma unroll
                    for (int bj = 0; bj < 2; ++bj)
#pragma unroll
                        for (int n = 0; n < 2; ++n) ss += (v[bj][n].x * v[bj][n].x + v[bj][n].y * v[bj][n].y) + (v[bj][n].z * v[bj][n].z + v[bj][n].w * v[bj][n].w);
                    ss += __shfl_xor(ss, 16); ss += __shfl_xor(ss, 32);
                    const float rstd = rsqrtf(ss * (1.f / 64.f) + EPS);
#pragma unroll
                    for (int bj = 0; bj < 2; ++bj)
#pragma unroll
                        for (int n = 0; n < 2; ++n) v[bj][n] = v[bj][n] * rstd * gq[bj][n];
                }
                bf16_t* pr = proj + (size_t)row * NPROJ + col0;
#pragma unroll
                for (int bj = 0; bj < 2; ++bj) { u32x4 w; w.x = cvt_pk_bf16(v[bj][0].x, v[bj][0].y); w.y = cvt_pk_bf16(v[bj][0].z, v[bj][0].w); w.z = cvt_pk_bf16(v[bj][1].x, v[bj][1].y); w.w = cvt_pk_bf16(v[bj][1].z, v[bj][1].w);
                    *(u32x4*)(pr + bj * 32) = w; }
                int b, t; if (!samp) { b = row >> 11; t = row & 2047; } else { b = (row - MP) >> 4; t = (row - MP) & 15; }
                if (grp <= 2) {
                    const int tl = samp ? t - 13 : t - 2045;
                    if (tl >= 0) { float* o = out + (samp ? O_CONV_S : O_CONV_P) + ((size_t)b * 3 + tl) * 1536 + col0;
#pragma unroll
                        for (int bj = 0; bj < 2; ++bj)
#pragma unroll
                            for (int n = 0; n < 2; ++n) *(f32x4*)(o + bj * 32 + n * 4) = v[bj][n]; }
                } else if (grp >= 5) {
                    const int cc = col0 - (grp == 5 ? C_KB : C_VB);
                    if (!samp) {
                        if (t >= 1536) { float* o = out + (grp == 5 ? O_KB_P : O_VB_P) + ((size_t)b * 512 + (t - 1536)) * 512 + cc;
#pragma unroll
                            for (int bj = 0; bj < 2; ++bj)
#pragma unroll
                                for (int n = 0; n < 2; ++n) *(f32x4*)(o + bj * 32 + n * 4) = v[bj][n]; }
                        if (grp == 6) {
                            LAS bf16_t* tb = (LAS bf16_t*)(xl + (wr * 4 + wc) * 2048);
#pragma unroll
                            for (int bj = 0; bj < 2; ++bj)
#pragma unroll
                                for (int n = 0; n < 2; ++n)
#pragma unroll
                                    for (int j = 0; j < 4; ++j) tb[(bj * 32 + fq * 8 + n * 4 + j) * 16 + fr] = f2bf(v[bj][n][j]);
                            asm volatile("s_waitcnt lgkmcnt(0)" ::: "memory");
                            const int ln = fq * 16 + fr;
                            const u32x4 lo = *(const LAS u32x4*)(tb + ln * 16), hi = *(const LAS u32x4*)(tb + ln * 16 + 8);
                            bf16_t* vp = vt + ((size_t)b * 512 + (cc - fq * 8) + ln) * 2048 + (t - fr);
                            *(u32x4*)vp = lo; *(u32x4*)(vp + 8) = hi;
                            asm volatile("s_waitcnt lgkmcnt(0)" ::: "memory");
                        }
                    } else { float* o = out + (grp == 5 ? O_KN_S : O_VN_S) + ((size_t)b * 16 + t) * 512 + cc;
#pragma unroll
                        for (int bj = 0; bj < 2; ++bj)
#pragma unroll
                            for (int n = 0; n < 2; ++n) *(f32x4*)(o + bj * 32 + n * 4) = v[bj][n]; }
                }
            }
    }
};
template <bool INPLACE>
struct EpiRes {
    static constexpr bool PERM = false, AFTER_DRAIN = false;
    const float* xp; const float* xs; const float* mod; int goff; float* out; bf16_t* x1b;
    __device__ __forceinline__ void operator()(const f32x4 (&acc)[2][2][4][2], const pg8::Unit& u, int wr, int wc, int fr, int fq) const {
        const int col0 = u.pn * 256 + wc * 64 + fq * 8;
#pragma unroll
        for (int ai = 0; ai < 2; ++ai)
#pragma unroll
            for (int m = 0; m < 4; ++m) {
                const int row = u.pm * 256 + ai * 128 + wr * 64 + m * 16 + fr;
                const int b = row_batch(row);
                float* o = out + (size_t)row * D + col0;
                bf16_t* xb = x1b + (size_t)row * D + col0;
                const float* gp = mod + (size_t)b * 6144 + goff + col0;
#pragma unroll
                for (int bj = 0; bj < 2; ++bj) {
                    const f32x4 g0 = *(const f32x4*)(gp + bj * 32), g1 = *(const f32x4*)(gp + bj * 32 + 4);
                    if (INPLACE) {
                        if (u.kq >= 0) {
                            const f32x4 d0 = g0 * acc[ai][bj][m][0], d1 = g1 * acc[ai][bj][m][1]; float* q = o + bj * 32;
                            unsafeAtomicAdd(q, d0.x); unsafeAtomicAdd(q + 1, d0.y); unsafeAtomicAdd(q + 2, d0.z); unsafeAtomicAdd(q + 3, d0.w);
                            unsafeAtomicAdd(q + 4, d1.x); unsafeAtomicAdd(q + 5, d1.y); unsafeAtomicAdd(q + 6, d1.z); unsafeAtomicAdd(q + 7, d1.w);
                        } else {
                            const u32x4 w = *(const u32x4*)(xb + bj * 32);
                            const f32x4 x0 = (f32x4){__uint_as_float(w.x << 16), __uint_as_float(w.x & 0xffff0000u), __uint_as_float(w.y << 16), __uint_as_float(w.y & 0xffff0000u)};
                            const f32x4 x1 = (f32x4){__uint_as_float(w.z << 16), __uint_as_float(w.z & 0xffff0000u), __uint_as_float(w.w << 16), __uint_as_float(w.w & 0xffff0000u)};
                            *(f32x4*)(o + bj * 32) = x0 + g0 * acc[ai][bj][m][0]; *(f32x4*)(o + bj * 32 + 4) = x1 + g1 * acc[ai][bj][m][1];
                        }
                    } else {
                        const float* base = (row < MP ? xp + (size_t)row * D : xs + (size_t)(row - MP) * D) + col0 + bj * 32;
                        const f32x4 y0 = *(const f32x4*)base + g0 * acc[ai][bj][m][0], y1 = *(const f32x4*)(base + 4) + g1 * acc[ai][bj][m][1];
                        u32x4 w; w.x = cvt_pk_bf16(y0.x, y0.y); w.y = cvt_pk_bf16(y0.z, y0.w); w.z = cvt_pk_bf16(y1.x, y1.y); w.w = cvt_pk_bf16(y1.z, y1.w);
                        *(u32x4*)(xb + bj * 32) = w;
                        if (u.pm == 256) { *(f32x4*)(o + bj * 32) = y0; *(f32x4*)(o + bj * 32 + 4) = y1; }
                    }
                }
            }
    }
};
struct EpiUp {
    static constexpr bool PERM = false, AFTER_DRAIN = false;
    bf16_t* hid;
    __device__ __forceinline__ void operator()(const f32x4 (&acc)[2][2][4][2], const pg8::Unit& u, int wr, int wc, int fr, int fq) const {
        const int col0 = u.pn * 256 + wc * 64 + fq * 8;
#pragma unroll
        for (int ai = 0; ai < 2; ++ai)
#pragma unroll
            for (int m = 0; m < 4; ++m) {
                const int row = u.pm * 256 + ai * 128 + wr * 64 + m * 16 + fr;
                bf16_t* o = hid + (size_t)row * DFF + col0;
#pragma unroll
                for (int bj = 0; bj < 2; ++bj) { f32x4 a = acc[ai][bj][m][0], c = acc[ai][bj][m][1];
                    a = __builtin_elementwise_max(a, (f32x4){0.f, 0.f, 0.f, 0.f}); c = __builtin_elementwise_max(c, (f32x4){0.f, 0.f, 0.f, 0.f}); a = a * a; c = c * c;
                    u32x4 w; w.x = cvt_pk_bf16(a.x, a.y); w.y = cvt_pk_bf16(a.z, a.w); w.z = cvt_pk_bf16(c.x, c.y); w.w = cvt_pk_bf16(c.z, c.w);
                    *(u32x4*)(o + bj * 32) = w; }
            }
    }
};

constexpr int G_RAW = 0, G_QS = 29184, G_KS = G_QS + 8192, G_VS = G_KS + 8192, G_OS = G_VS + 8192, G_PART = G_OS + 8192, G_CW = G_PART + 8192, G_SA = G_CW + 6144, G_SB = G_SA + 64, G_QK = G_SB + 64;
__device__ __forceinline__ void gdn_item(const Params& p, LAS unsigned char* L, int rowbase, int T, int h, const float* s0, const float* left, float* sout, int tid_in, int wave, int lane_in) {
    const int tid = opq(tid_in), lane = tid & 63;
    const bf16_t* proj = (const bf16_t*)(p.ws + WS_PROJ);
    const float* BA = (const float*)(p.ws + WS_BA);
    bf16_t* mix = (bf16_t*)(p.ws + WS_MIX);
    LAS float* raw = (LAS float*)(L + G_RAW); LAS float* qs = (LAS float*)(L + G_QS); LAS float* ks = (LAS float*)(L + G_KS); LAS float* vs = (LAS float*)(L + G_VS);
    LAS float* os = (LAS float*)(L + G_OS); LAS f32x2* part = (LAS f32x2*)(L + G_PART); LAS float* cw = (LAS float*)(L + G_CW);
    LAS float* sa = (LAS float*)(L + G_SA); LAS float* sb = (LAS float*)(L + G_SB); LAS float* sqk = (LAS float*)(L + G_QK);
    const int dv = tid & 127, kg = tid >> 7;
    float S[32];
#pragma unroll
    for (int i = 0; i < 32; ++i) S[i] = s0 ? s0[(size_t)(kg * 32 + i) * 128 + dv] : 0.f;
    const float* convw = p.in[13];
    for (int i = tid; i < 4 * 384; i += NTHREADS) { const int tap = i / 384, ch = i % 384; cw[i] = convw[tap * 1536 + (ch >> 7) * 512 + h * 128 + (ch & 127)]; }
    const float nAexp = -__expf(p.in[14][h]), dtb = p.in[15][h];
    const float gn0 = p.in[16][lane], gn1 = p.in[16][lane + 64];
    int buf = 0;
    for (int t0 = 0; t0 < T; t0 += 16) {
        for (int i = tid; i < 19 * 48; i += NTHREADS) {
            const int r = i / 48, seg = i % 48, part_ = seg >> 4, off = (seg & 15) * 8, t = t0 - 3 + r;
            float v8[8];
            if (t >= 0) { const u32x4 w = *(const u32x4*)(proj + (size_t)(rowbase + t) * NPROJ + part_ * 512 + h * 128 + off);
                v8[0] = __uint_as_float(w.x << 16); v8[1] = __uint_as_float(w.x & 0xffff0000u); v8[2] = __uint_as_float(w.y << 16); v8[3] = __uint_as_float(w.y & 0xffff0000u);
                v8[4] = __uint_as_float(w.z << 16); v8[5] = __uint_as_float(w.z & 0xffff0000u); v8[6] = __uint_as_float(w.w << 16); v8[7] = __uint_as_float(w.w & 0xffff0000u); }
            else if (left) { const float* lp = left + (size_t)(3 + t) * 1536 + part_ * 512 + h * 128 + off;
#pragma unroll
                for (int e = 0; e < 8; ++e) v8[e] = lp[e]; }
            else {
#pragma unroll
                for (int e = 0; e < 8; ++e) v8[e] = 0.f; }
            LAS float* d = raw + r * 384 + part_ * 128 + off;
            *(LAS f32x4*)d = (f32x4){v8[0], v8[1], v8[2], v8[3]}; *(LAS f32x4*)(d + 4) = (f32x4){v8[4], v8[5], v8[6], v8[7]};
        }
        __syncthreads();
        for (int i = tid; i < 16 * 384; i += NTHREADS) {
            const int tok = i / 384, ch = i % 384;
            const float a = cw[ch] * raw[tok * 384 + ch] + cw[384 + ch] * raw[(tok + 1) * 384 + ch] + cw[768 + ch] * raw[(tok + 2) * 384 + ch] + cw[1152 + ch] * raw[(tok + 3) * 384 + ch];
            const float y = silu_f(a);
            LAS float* dst = (ch < 128) ? qs : (ch < 256 ? ks : vs);
            dst[tok * 128 + (ch & 127)] = y;
        }
        __syncthreads();
#pragma unroll
        for (int rr = 0; rr < 2; ++rr) {
            const int tok = wave + 8 * rr;
            const float q0 = qs[tok * 128 + lane], q1 = qs[tok * 128 + lane + 64], k0 = ks[tok * 128 + lane], k1 = ks[tok * 128 + lane + 64];
            const float sq = wave_sum(q0 * q0 + q1 * q1), sk = wave_sum(k0 * k0 + k1 * k1), qk = wave_sum(q0 * k0 + q1 * k1);
            const float rq = rsqrtf(sq + EPS) * 0.08838834764831845f, rk = rsqrtf(sk + EPS);
            qs[tok * 128 + lane] = q0 * rq; qs[tok * 128 + lane + 64] = q1 * rq; ks[tok * 128 + lane] = k0 * rk; ks[tok * 128 + lane + 64] = k1 * rk;
            if (lane == 0) {
                const size_t row = (size_t)(rowbase + t0 + tok);
                const float braw = BA[row * 8 + h], araw = BA[row * 8 + 4 + h] + dtb;
                const float sp = araw > 20.f ? araw : log1pf(__expf(araw));
                sa[tok] = __expf(nAexp * sp); sb[tok] = 1.f / (1.f + __expf(-braw)); sqk[tok] = qk * rq * rk;
            }
        }
        __syncthreads();
        for (int tok = 0; tok < 16; ++tok) {
            f32x4 kk[8], qq[8];
#pragma unroll
            for (int i = 0; i < 8; ++i) { kk[i] = *(const LAS f32x4*)(ks + tok * 128 + kg * 32 + 4 * i); qq[i] = *(const LAS f32x4*)(qs + tok * 128 + kg * 32 + 4 * i); }
            float pk = 0.f, pq = 0.f;
#pragma unroll
            for (int i = 0; i < 8; ++i) {
                pk += kk[i].x * S[4 * i] + kk[i].y * S[4 * i + 1] + kk[i].z * S[4 * i + 2] + kk[i].w * S[4 * i + 3];
                pq += qq[i].x * S[4 * i] + qq[i].y * S[4 * i + 1] + qq[i].z * S[4 * i + 2] + qq[i].w * S[4 * i + 3]; }
            part[(buf * 4 + kg) * 128 + dv] = (f32x2){pk, pq};
            __syncthreads();
            const f32x2 p0 = part[(buf * 4 + 0) * 128 + dv], p1 = part[(buf * 4 + 1) * 128 + dv], p2 = part[(buf * 4 + 2) * 128 + dv], p3 = part[(buf * 4 + 3) * 128 + dv];
            const float kS = (p0.x + p1.x) + (p2.x + p3.x), qS = (p0.y + p1.y) + (p2.y + p3.y);
            const float a = sa[tok], bt = sb[tok], qkv = sqk[tok], vv = vs[tok * 128 + dv];
            const float dlt = bt * (vv - a * kS);
#pragma unroll
            for (int i = 0; i < 8; ++i) {
                S[4 * i] = a * S[4 * i] + kk[i].x * dlt; S[4 * i + 1] = a * S[4 * i + 1] + kk[i].y * dlt; S[4 * i + 2] = a * S[4 * i + 2] + kk[i].z * dlt; S[4 * i + 3] = a * S[4 * i + 3] + kk[i].w * dlt; }
            if (kg == 0) os[tok * 128 + dv] = a * qS + qkv * dlt;
            buf ^= 1;
        }
        __syncthreads();
#pragma unroll
        for (int rr = 0; rr < 2; ++rr) {
            const int tok = wave + 8 * rr; const size_t row = (size_t)(rowbase + t0 + tok);
            const float o0 = os[tok * 128 + lane], o1 = os[tok * 128 + lane + 64];
            const float rstd = rsqrtf(wave_sum(o0 * o0 + o1 * o1) * (1.f / 128.f) + EPS);
            const float g0 = bf2f(proj[row * NPROJ + C_GA + h * 128 + lane]), g1 = bf2f(proj[row * NPROJ + C_GA + h * 128 + lane + 64]);
            mix[row * D + h * 128 + lane] = f2bf(o0 * rstd * gn0 * silu_f(g0));
            mix[row * D + h * 128 + lane + 64] = f2bf(o1 * rstd * gn1 * silu_f(g1));
        }
    }
#pragma unroll
    for (int i = 0; i < 32; ++i) sout[(size_t)(kg * 32 + i) * 128 + dv] = S[i];
    __syncthreads();
}

template <int J, int... II> __device__ __forceinline__ void fs_col_apply(float (&x)[32], const float (&mv)[2], std::integer_sequence<int, II...>) {
    (fmac_bc<(J + 1 + II) & 15>(x[J + 1 + II], mv[(J + 1 + II) >> 4], x[J]), ...);
}
template <int J> __device__ __forceinline__ void fs_col_load(float (&mv)[2], const LAS float* Mb, int l15) {
#pragma unroll
    for (int q = 0; q < 2; ++q) if (16 * q + 15 > J) mv[q] = Mb[(16 * q + l15) * 68 + J];
}
template <int J> __device__ __forceinline__ void fs_col(float (&x)[32], float (&mvc)[2], const LAS float* Mb, int l15) {
    float mvn[2] = {0.f, 0.f};
    if constexpr (J + 1 < 31) fs_col_load<J + 1>(mvn, Mb, l15);
    fs_col_apply<J>(x, mvc, std::make_integer_sequence<int, 31 - J>{});
#pragma unroll
    for (int q = 0; q < 2; ++q) mvc[q] = mvn[q];
}
template <int... JJ> __device__ __forceinline__ void fs_all(float (&x)[32], const LAS float* Mb, int l15, std::integer_sequence<int, JJ...>) {
    float mvc[2] = {0.f, 0.f}; fs_col_load<0>(mvc, Mb, l15); (fs_col<JJ>(x, mvc, Mb, l15), ...);
}
constexpr int CS_Q = 136, CS_VU = 132, CS_M = 68, CS_T = 72;
constexpr int C_M = 0, C_Q = 17408, C_QG = 34816, C_K = 52224, C_KDT = 69632, C_VU = 88064, C_QKM = 121856, C_SC = 131072;
#define LDS_BARRIER() do { asm volatile("s_waitcnt lgkmcnt(0)" ::: "memory"); __builtin_amdgcn_s_barrier(); asm volatile("" ::: "memory"); } while (0)
__device__ __forceinline__ void gdn_chunk_item(const Params& p, LAS unsigned char* L, int b, int h, float* sout, int tid_unused, int wave, int lane_in) {
    int lane = opq(lane_in);
    const bf16_t* proj = (const bf16_t*)(p.ws + WS_PROJ);
    const float* BA = (const float*)(p.ws + WS_BA);
    bf16_t* mix = (bf16_t*)(p.ws + WS_MIX);
    LAS bf16_t* Qb = (LAS bf16_t*)(L + C_Q); LAS bf16_t* QGb = (LAS bf16_t*)(L + C_QG); LAS bf16_t* Kb = (LAS bf16_t*)(L + C_K); LAS bf16_t* KDt = (LAS bf16_t*)(L + C_KDT);
    LAS float* VU = (LAS float*)(L + C_VU); LAS float* Mm = (LAS float*)(L + C_M); LAS bf16_t* QKm = (LAS bf16_t*)(L + C_QKM);
    LAS float* sgc = (LAS float*)(L + C_SC); LAS float* sbeta = sgc + 64; LAS float* sbg = sgc + 128;
    LAS bf16_t* Wb = Qb;
    int fr = lane & 15, g = lane >> 4;
    const size_t rowbase = (size_t)b * TP;
    float cw[4][3][2];
#pragma unroll
    for (int tap = 0; tap < 4; ++tap)
#pragma unroll
        for (int pt = 0; pt < 3; ++pt) { const f32x2 t = *(const f32x2*)(p.in[13] + tap * 1536 + pt * 512 + h * 128 + 2 * lane); cw[tap][pt][0] = t.x; cw[tap][pt][1] = t.y; }
    const float nAexp = -__expf(p.in[14][h]), dtb = p.in[15][h];
    const f32x2 gn = *(const f32x2*)(p.in[16] + 2 * lane);
    f32x4 Sacc[8];
#pragma unroll
    for (int i = 0; i < 8; ++i) Sacc[i] = (f32x4){0.f, 0.f, 0.f, 0.f};
    float pf_b, pf_a; unsigned pf_raw[11][3], pf_gate[8];
#define GDN_PREFETCH(T0) do { const int t0n_ = (T0); \
        { const size_t row_ = rowbase + t0n_ + lane; pf_b = BA[row_ * 8 + h]; pf_a = BA[row_ * 8 + 4 + h]; } \
        _Pragma("unroll") for (int r = 0; r < 11; ++r) { const int tr = t0n_ + 8 * wave - 3 + r; \
            _Pragma("unroll") for (int pt = 0; pt < 3; ++pt) pf_raw[r][pt] = (tr >= 0) ? *(const unsigned*)(proj + (rowbase + tr) * NPROJ + pt * 512 + h * 128 + 2 * lane) : 0u; } \
        _Pragma("unroll") for (int j = 0; j < 8; ++j) pf_gate[j] = *(const unsigned*)(proj + (rowbase + t0n_ + 8 * wave + j) * NPROJ + C_GA + h * 128 + 2 * lane); } while (0)
    GDN_PREFETCH(0);
    for (int c = 0; c < 32; ++c) {
        const int t0 = c * 64;
        lane = opq(lane_in);
        float beta, gcs, gam, kdl, glast, gl0, gl1;
        {
            const float braw = pf_b, araw = pf_a + dtb;
            const float sp = araw > 20.f ? araw : __logf(1.f + __expf(araw));
            gcs = nAexp * sp; beta = sigmoid_f(braw);
            gcs += dpp_f<0x111>(gcs); gcs += dpp_f<0x112>(gcs); gcs += dpp_f<0x114>(gcs); gcs += dpp_f<0x118>(gcs);
            { const float t15 = __int_as_float(__builtin_amdgcn_readlane(__float_as_int(gcs), 15)), t47 = __int_as_float(__builtin_amdgcn_readlane(__float_as_int(gcs), 47));
              if (lane & 16) gcs += (lane < 32) ? t15 : t47; }
            gl0 = __int_as_float(__builtin_amdgcn_readlane(__float_as_int(gcs), 31)); gl1 = __int_as_float(__builtin_amdgcn_readlane(__float_as_int(gcs), 63)); glast = lane < 32 ? gl0 : gl1;
            gam = __expf(gcs); kdl = __expf(glast - gcs);
            if (wave == 0) { sgc[lane] = gcs; sbeta[lane] = beta; sbg[lane] = beta * gam; }
        }
        unsigned gatev[8];
        {
#pragma unroll
            for (int j = 0; j < 8; ++j) gatev[j] = pf_gate[j];
#pragma unroll
            for (int j = 0; j < 8; ++j) {
                const int tok = 8 * wave + j;
                float y[3][2];
#pragma unroll
                for (int pt = 0; pt < 3; ++pt) { float a0 = 0.f, a1 = 0.f;
#pragma unroll
                    for (int tap = 0; tap < 4; ++tap) { const unsigned u = pf_raw[j + tap][pt]; a0 += cw[tap][pt][0] * __uint_as_float(u << 16); a1 += cw[tap][pt][1] * __uint_as_float(u & 0xffff0000u); }
                    y[pt][0] = silu_f(a0); y[pt][1] = silu_f(a1); }
                const float rq = rsqrtf(wave_sum_u(y[0][0] * y[0][0] + y[0][1] * y[0][1]) + EPS) * 0.08838834764831845f;
                const float rk = rsqrtf(wave_sum_u(y[1][0] * y[1][0] + y[1][1] * y[1][1]) + EPS);
                const float gm = __int_as_float(__builtin_amdgcn_readlane(__float_as_int(gam), tok)), bt = __int_as_float(__builtin_amdgcn_readlane(__float_as_int(beta), tok)), kd = __int_as_float(__builtin_amdgcn_readlane(__float_as_int(kdl), tok));
                const float q0 = y[0][0] * rq, q1 = y[0][1] * rq, k0 = y[1][0] * rk, k1 = y[1][1] * rk;
                *(LAS unsigned*)(Qb + tok * CS_Q + 2 * lane) = cvt_pk_bf16(q0, q1);
                *(LAS unsigned*)(QGb + tok * CS_Q + 2 * lane) = cvt_pk_bf16(q0 * gm, q1 * gm);
                *(LAS unsigned*)(Kb + tok * CS_Q + 2 * lane) = cvt_pk_bf16(k0, k1);
                const unsigned kdp = cvt_pk_bf16(k0 * kd, k1 * kd);
                KDt[(2 * lane) * CS_T + tok] = (bf16_t)(kdp & 0xffffu); KDt[(2 * lane + 1) * CS_T + tok] = (bf16_t)(kdp >> 16);
                *(LAS f32x2*)(VU + tok * CS_VU + 2 * lane) = (f32x2){bt * y[2][0], bt * y[2][1]};
            }
            if (c + 1 < 32) GDN_PREFETCH(t0 + 64);
        }
        LDS_BARRIER();
        lane = opq(lane_in); fr = lane & 15; g = lane >> 4; const int tid = wave * 64 + lane;
        { const int hf = tid >> 8, i = (tid >> 4) & 15, j = tid & 15; QKm[(32 * hf + i) * CS_T + 32 * hf + 16 + j] = 0; }
        for (int tix = wave; tix < 12; tix += 8) {
            const int kind = tix >= 6 ? 1 : 0, tl = tix - 6 * kind;
            const int it = tl < 3 ? (tl >= 1 ? 1 : 0) : (tl >= 4 ? 3 : 2), jt = tl < 3 ? (tl == 2 ? 1 : 0) : (tl == 5 ? 3 : 2);
            const LAS bf16_t* As = kind ? Qb : Kb;
            f32x4 acc = (f32x4){0.f, 0.f, 0.f, 0.f};
#pragma unroll
            for (int ks = 0; ks < 4; ++ks) { const bf16x8 a = *(const LAS bf16x8*)(As + (it * 16 + fr) * CS_Q + ks * 32 + g * 8), bb = *(const LAS bf16x8*)(Kb + (jt * 16 + fr) * CS_Q + ks * 32 + g * 8);
                acc = __builtin_amdgcn_mfma_f32_16x16x32_bf16(a, bb, acc, 0, 0, 0); }
            const int j = jt * 16 + fr; const float gcj = sgc[j];
#pragma unroll
            for (int r = 0; r < 4; ++r) { const int i = it * 16 + 4 * g + r; const float dec = __expf(fminf(sgc[i] - gcj, 0.f));
                if (kind == 0) Mm[i * CS_M + j] = (i > j) ? -(acc[r] * dec * sbeta[i]) : 0.f;
                else QKm[i * CS_T + j] = (i >= j) ? f2bf(acc[r] * dec) : (bf16_t)0; }
        }
        LDS_BARRIER();
        {
            float x[32];
            const int l3 = opq(lane_in), sub = wave >> 2, wq = wave & 3, cc = (wq & 1) * 64 + l3, r0 = 32 * sub;
            if (wq < 2) {
#pragma unroll
                for (int i = 0; i < 32; ++i) x[i] = VU[(r0 + i) * CS_VU + cc];
            } else {
#pragma unroll
                for (int i = 0; i < 32; ++i) x[i] = bf2f(Kb[(r0 + i) * CS_Q + cc]) * sbg[r0 + i];
            }
            fs_all(x, Mm + r0 * CS_M + r0, l3 & 15, std::make_integer_sequence<int, 31>{});
            if (wq < 2) {
#pragma unroll
                for (int i = 0; i < 32; ++i) VU[(r0 + i) * CS_VU + cc] = x[i];
            } else {
#pragma unroll
                for (int i = 0; i < 32; ++i) Wb[(r0 + i) * CS_Q + cc] = f2bf(-x[i]);
            }
        }
        LDS_BARRIER();
        lane = opq(lane_in); fr = lane & 15; g = lane >> 4;
#pragma unroll
        for (int sub = 0; sub < 2; ++sub) {
            const float glw = __expf(sub ? gl1 : gl0);
            f32x4 ua[2]; u32x2 wf[2][4][2], qf[2][4][2], mf[2][2], kf[8][2];
#pragma unroll
            for (int t2 = 0; t2 < 2; ++t2) { const int tt = 2 * sub + t2;
#pragma unroll
                for (int r = 0; r < 4; ++r) ua[t2][r] = VU[(tt * 16 + 4 * g + r) * CS_VU + 16 * wave + fr];
#pragma unroll
                for (int ks = 0; ks < 4; ++ks) { const LAS bf16_t* wp = Wb + (tt * 16 + fr) * CS_Q + ks * 32 + 4 * g; const LAS bf16_t* qp = QGb + (tt * 16 + fr) * CS_Q + ks * 32 + 4 * g;
                    wf[t2][ks][0] = *(const LAS u32x2*)wp; wf[t2][ks][1] = *(const LAS u32x2*)(wp + 16); qf[t2][ks][0] = *(const LAS u32x2*)qp; qf[t2][ks][1] = *(const LAS u32x2*)(qp + 16); } }
            asm volatile("s_waitcnt lgkmcnt(0)" ::: "memory");
            bf16x8 Sb[4];
#pragma unroll
            for (int ks = 0; ks < 4; ++ks) { const f32x4 lo = Sacc[2 * ks], hi = Sacc[2 * ks + 1];
                const u32x4 w = (u32x4){cvt_pk_bf16(lo.x, lo.y), cvt_pk_bf16(lo.z, lo.w), cvt_pk_bf16(hi.x, hi.y), cvt_pk_bf16(hi.z, hi.w)}; Sb[ks] = __builtin_bit_cast(bf16x8, w); }
            f32x4 vn[2], oo[2];
#pragma unroll
            for (int t2 = 0; t2 < 2; ++t2) { vn[t2] = ua[t2]; oo[t2] = (f32x4){0.f, 0.f, 0.f, 0.f}; }
#pragma unroll
            for (int ks = 0; ks < 4; ++ks)
#pragma unroll
                for (int t2 = 0; t2 < 2; ++t2) {
                    const u32x4 wa = (u32x4){wf[t2][ks][0].x, wf[t2][ks][0].y, wf[t2][ks][1].x, wf[t2][ks][1].y}, qa = (u32x4){qf[t2][ks][0].x, qf[t2][ks][0].y, qf[t2][ks][1].x, qf[t2][ks][1].y};
                    vn[t2] = __builtin_amdgcn_mfma_f32_16x16x32_bf16(__builtin_bit_cast(bf16x8, wa), Sb[ks], vn[t2], 0, 0, 0);
                    oo[t2] = __builtin_amdgcn_mfma_f32_16x16x32_bf16(__builtin_bit_cast(bf16x8, qa), Sb[ks], oo[t2], 0, 0, 0);
                }
            __builtin_amdgcn_sched_barrier(0);
#pragma unroll
            for (int t2 = 0; t2 < 2; ++t2) { const LAS bf16_t* ap = QKm + ((2 * sub + t2) * 16 + fr) * CS_T + 32 * sub + 4 * g; mf[t2][0] = *(const LAS u32x2*)ap; mf[t2][1] = *(const LAS u32x2*)(ap + 16); }
#pragma unroll
            for (int dkt = 0; dkt < 8; ++dkt) { const LAS bf16_t* ap = KDt + (dkt * 16 + fr) * CS_T + 32 * sub + 4 * g; kf[dkt][0] = *(const LAS u32x2*)ap; kf[dkt][1] = *(const LAS u32x2*)(ap + 16); }
            asm volatile("s_waitcnt lgkmcnt(0)" ::: "memory");
            bf16x8 Vb;
            { const f32x4 lo = vn[0], hi = vn[1];
                const u32x4 w = (u32x4){cvt_pk_bf16(lo.x, lo.y), cvt_pk_bf16(lo.z, lo.w), cvt_pk_bf16(hi.x, hi.y), cvt_pk_bf16(hi.z, hi.w)}; Vb = __builtin_bit_cast(bf16x8, w); }
#pragma unroll
            for (int dkt = 0; dkt < 8; ++dkt) { const u32x4 aa = (u32x4){kf[dkt][0].x, kf[dkt][0].y, kf[dkt][1].x, kf[dkt][1].y};
                Sacc[dkt] = __builtin_amdgcn_mfma_f32_16x16x32_bf16(__builtin_bit_cast(bf16x8, aa), Vb, Sacc[dkt] * glw, 0, 0, 0); }
#pragma unroll
            for (int t2 = 0; t2 < 2; ++t2) { const int tt = 2 * sub + t2;
                const u32x4 aa = (u32x4){mf[t2][0].x, mf[t2][0].y, mf[t2][1].x, mf[t2][1].y};
                const f32x4 o = __builtin_amdgcn_mfma_f32_16x16x32_bf16(__builtin_bit_cast(bf16x8, aa), Vb, oo[t2], 0, 0, 0);
#pragma unroll
                for (int r = 0; r < 4; ++r) VU[(tt * 16 + 4 * g + r) * CS_VU + 16 * wave + fr] = o[r]; }
        }
        LDS_BARRIER();
        lane = opq(lane_in);
#pragma unroll
        for (int j = 0; j < 8; ++j) {
            const int tok = 8 * wave + j;
            const f32x2 o = *(const LAS f32x2*)(VU + tok * CS_VU + 2 * lane);
            const float rstd = rsqrtf(wave_sum_u(o.x * o.x + o.y * o.y) * (1.f / 128.f) + EPS);
            const float g0 = __uint_as_float(gatev[j] << 16), g1 = __uint_as_float(gatev[j] & 0xffff0000u);
            *(unsigned*)(mix + (rowbase + t0 + tok) * D + h * 128 + 2 * lane) = cvt_pk_bf16(o.x * rstd * gn.x * silu_f(g0), o.y * rstd * gn.y * silu_f(g1));
        }
    }
    lane = opq(lane_in); fr = lane & 15; g = lane >> 4;
#pragma unroll
    for (int dkt = 0; dkt < 8; ++dkt)
#pragma unroll
        for (int r = 0; r < 4; ++r) sout[(size_t)(dkt * 16 + 4 * g + r) * 128 + 16 * wave + fr] = Sacc[dkt][r];
#undef GDN_PREFETCH
    __syncthreads();
}

constexpr int A_TB = 132096;
__device__ __forceinline__ void attn_prompt_item(const Params& p, LAS unsigned char* L, int b, int c, int wave, int lane_in) {
    const int lane = opq(lane_in);
    const bf16_t* proj = (const bf16_t*)(p.ws + WS_PROJ);
    const bf16_t* vt = (const bf16_t*)(p.ws + WS_VT);
    bf16_t* mix = (bf16_t*)(p.ws + WS_MIX);
    const int h = wave, fr = lane & 15, g = lane >> 4;
    const LAS float* Tb = (const LAS float*)(L + A_TB) + h * 320;
    const size_t rowq0 = (size_t)b * TP + c * 64;
    bf16x8 Qf[4][2];
#pragma unroll
    for (int qt = 0; qt < 4; ++qt)
#pragma unroll
        for (int ks = 0; ks < 2; ++ks) Qf[qt][ks] = *(const bf16x8*)(proj + (rowq0 + qt * 16 + fr) * NPROJ + C_QB + h * 64 + ks * 32 + g * 8);
    f32x4 O[4][4]; float ls[4];
#pragma unroll
    for (int dt = 0; dt < 4; ++dt)
#pragma unroll
        for (int qt = 0; qt < 4; ++qt) O[dt][qt] = (f32x4){0.f, 0.f, 0.f, 0.f};
#pragma unroll
    for (int qt = 0; qt < 4; ++qt) ls[qt] = 0.f;
    const int jc0 = (c < 8) ? (8 - c) : 0;
    bf16x8 Kn[2][2], Vn[4];
#define ATT_LOAD(JT) do { const int tok0_ = c * 64 - 512 + (JT) * 32; \
        _Pragma("unroll") for (int kt = 0; kt < 2; ++kt) _Pragma("unroll") for (int ks = 0; ks < 2; ++ks) \
            Kn[kt][ks] = *(const bf16x8*)(proj + ((size_t)b * TP + tok0_ + kt * 16 + fr) * NPROJ + C_KB + h * 64 + ks * 32 + g * 8); \
        _Pragma("unroll") for (int dt = 0; dt < 4; ++dt) { const bf16_t* vp = vt + ((size_t)b * 512 + h * 64 + dt * 16 + fr) * 2048 + tok0_ + 4 * g; \
            const u32x2 lo = *(const u32x2*)vp, hi = *(const u32x2*)(vp + 16); const u32x4 w = (u32x4){lo.x, lo.y, hi.x, hi.y}; Vn[dt] = __builtin_bit_cast(bf16x8, w); } } while (0)
    ATT_LOAD(jc0 * 2);
    for (int jt = jc0 * 2; jt < 18; ++jt) {
        const int kj0 = jt * 32;
        bf16x8 Kf[2][2], Vf[4];
#pragma unroll
        for (int kt = 0; kt < 2; ++kt)
#pragma unroll
            for (int ks = 0; ks < 2; ++ks) Kf[kt][ks] = Kn[kt][ks];
#pragma unroll
        for (int dt = 0; dt < 4; ++dt) Vf[dt] = Vn[dt];
        if (jt + 1 < 18) ATT_LOAD(jt + 1);
        f32x4 St[2][4];
#pragma unroll
        for (int kt = 0; kt < 2; ++kt)
#pragma unroll
            for (int qt = 0; qt < 4; ++qt) { St[kt][qt] = (f32x4){0.f, 0.f, 0.f, 0.f};
#pragma unroll
                for (int ks = 0; ks < 2; ++ks) St[kt][qt] = __builtin_amdgcn_mfma_f32_16x16x32_bf16(Kf[kt][ks], Qf[qt][ks], St[kt][qt], 0, 0, 0); }
        bf16x8 Pf[4];
#pragma unroll
        for (int qt = 0; qt < 4; ++qt) {
            float e[8];
            if (jt < 8) {
                const float tb = Tb[319];
#pragma unroll
                for (int kt = 0; kt < 2; ++kt)
#pragma unroll
                    for (int r = 0; r < 4; ++r) { const float x = __builtin_amdgcn_exp2f(St[kt][qt][r] + tb); e[kt * 4 + r] = x; ls[qt] += x; }
            } else {
#pragma unroll
            for (int kt = 0; kt < 2; ++kt)
#pragma unroll
                for (int r = 0; r < 4; ++r) { const int key = kt * 16 + 4 * g + r, qi = qt * 16 + fr; int idx = qi - (kj0 + key) + 575; idx = idx > 319 ? 319 : idx;
                    const float x = __builtin_amdgcn_exp2f(St[kt][qt][r] + Tb[idx]); e[kt * 4 + r] = x; ls[qt] += x; }
            }
            const u32x4 w = (u32x4){cvt_pk_bf16(e[0], e[1]), cvt_pk_bf16(e[2], e[3]), cvt_pk_bf16(e[4], e[5]), cvt_pk_bf16(e[6], e[7])};
            Pf[qt] = __builtin_bit_cast(bf16x8, w);
        }
#pragma unroll
        for (int dt = 0; dt < 4; ++dt)
#pragma unroll
            for (int qt = 0; qt < 4; ++qt) O[dt][qt] = __builtin_amdgcn_mfma_f32_16x16x32_bf16(Vf[dt], Pf[qt], O[dt][qt], 0, 0, 0);
    }
#undef ATT_LOAD
#pragma unroll
    for (int qt = 0; qt < 4; ++qt) {
        float l = ls[qt]; l += __shfl_xor(l, 16); l += __shfl_xor(l, 32); const float inv = 1.f / l;
        bf16_t* o = mix + (rowq0 + qt * 16 + fr) * D + 512 + h * 64 + 4 * g;
#pragma unroll
        for (int dt = 0; dt < 4; ++dt) { const f32x4 v = O[dt][qt] * inv; u32x2 w; w.x = cvt_pk_bf16(v.x, v.y); w.y = cvt_pk_bf16(v.z, v.w); *(u32x2*)(o + dt * 16) = w; }
    }
}

constexpr int SA_Q = 0, SA_SC = 4096, SA_RI = SA_SC + 16 * 528 * 4;
__device__ __forceinline__ void attn_sample_item(const Params& p, LAS unsigned char* L, int sbi, int h, int tid_in, int wave, int lane_in) {
    const int tid = opq(tid_in), lane = tid & 63;
    const bf16_t* proj = (const bf16_t*)(p.ws + WS_PROJ);
    bf16_t* mix = (bf16_t*)(p.ws + WS_MIX);
    const float* ck = p.in[4]; const float* cv = p.in[5]; const float* rb = p.in[19] + h * 320;
    LAS float* qs = (LAS float*)(L + SA_Q); LAS float* sc = (LAS float*)(L + SA_SC); LAS float* ri = (LAS float*)(L + SA_RI);
    const size_t row0 = (size_t)MP + sbi * 16;
    for (int i = tid; i < 1024; i += NTHREADS) qs[i] = bf2f(proj[(row0 + (i >> 6)) * NPROJ + C_QB + h * 64 + (i & 63)]);
    __syncthreads();
#pragma unroll 1
    for (int pass = 0; pass < 2; ++pass) {
        const int j = pass * 512 + tid;
        if (j < 528) {
            float kr[64];
            if (pass == 0) { const float* kp = ck + (((size_t)sbi * 512 + j) * 8 + h) * 64;
#pragma unroll
                for (int d = 0; d < 16; ++d) { const f32x4 t = *(const f32x4*)(kp + 4 * d); kr[4 * d] = t.x; kr[4 * d + 1] = t.y; kr[4 * d + 2] = t.z; kr[4 * d + 3] = t.w; } }
            else { const bf16_t* kp = proj + (row0 + (j - 512)) * NPROJ + C_KB + h * 64;
#pragma unroll
                for (int d = 0; d < 64; ++d) kr[d] = bf2f(kp[d]); }
            for (int qi = 0; qi < 16; ++qi) {
                float s = 0.f;
#pragma unroll
                for (int d = 0; d < 16; ++d) { const f32x4 q = *(const LAS f32x4*)(qs + qi * 64 + 4 * d); s += (q.x * kr[4 * d] + q.y * kr[4 * d + 1]) + (q.z * kr[4 * d + 2] + q.w * kr[4 * d + 3]); }
                int dd = qi + 512 - j; dd = dd > 256 ? 256 : dd;
                sc[qi * 528 + j] = s + rb[dd + 63] * LOG2E;
            }
        }
    }
    __syncthreads();
#pragma unroll
    for (int rr = 0; rr < 2; ++rr) {
        const int qi = 2 * wave + rr; float m = -3.0e38f;
        for (int j = lane; j < 528; j += 64) m = fmaxf(m, sc[qi * 528 + j]);
        m = wave_max(m); float s = 0.f;
        for (int j = lane; j < 528; j += 64) { const float e = __builtin_amdgcn_exp2f(sc[qi * 528 + j] - m); sc[qi * 528 + j] = e; s += e; }
        s = wave_sum(s); if (lane == 0) ri[qi] = 1.f / s;
    }
    __syncthreads();
    {
        const int dv = tid & 63, ig = tid >> 6; float o0 = 0.f, o1 = 0.f;
        const float* vp = cv + ((size_t)sbi * 512 * 8 + h) * 64 + dv;
#pragma unroll 8
        for (int j = 0; j < 512; ++j) { const float v = vp[(size_t)j * 512]; o0 += sc[(2 * ig) * 528 + j] * v; o1 += sc[(2 * ig + 1) * 528 + j] * v; }
#pragma unroll
        for (int j = 0; j < 16; ++j) { const float v = bf2f(proj[(row0 + j) * NPROJ + C_VB + h * 64 + dv]); o0 += sc[(2 * ig) * 528 + 512 + j] * v; o1 += sc[(2 * ig + 1) * 528 + 512 + j] * v; }
        mix[(row0 + 2 * ig) * D + 512 + h * 64 + dv] = f2bf(o0 * ri[2 * ig]);
        mix[(row0 + 2 * ig + 1) * D + 512 + h * 64 + dv] = f2bf(o1 * ri[2 * ig + 1]);
    }
    __syncthreads();
}

constexpr int Q_GDN_P = 128, Q_GDN_S = 64, Q_ATT_S = 128, Q_ATT_P = 1024, Q_TOTAL = Q_GDN_P + Q_GDN_S + Q_ATT_S + Q_ATT_P;
constexpr int L_ITEM = 142336;
__device__ __forceinline__ void phase3(const Params& p, LAS unsigned char* L, int tid_in, int wave, int lane_in) {
    const int tid = opq(tid_in), lane = tid & 63;
    {
        const float* rb = p.in[19] + wave * 320;
        const float qm = wave_max(fabsf(p.in[17][lane])), km = wave_max(fabsf(p.in[18][lane]));
        float bm = -3.0e38f;
        for (int i = lane; i < 320; i += 64) bm = fmaxf(bm, rb[i]);
        bm = wave_max(bm);
        const float bound = 8.f * qm * km + bm;
        LAS float* Tb = (LAS float*)(L + A_TB) + wave * 320;
        for (int i = lane; i < 320; i += 64) Tb[i] = (rb[i] - bound) * LOG2E;
    }
    __syncthreads();
    unsigned* ctr = (unsigned*)(p.ws + WS_CTL);
    volatile LAS int* sitem = (volatile LAS int*)(L + L_ITEM);
    for (;;) {
        if (tid == 0) *sitem = (int)atomicAdd(ctr, 1u);
        __syncthreads();
        int it = *sitem;
        __syncthreads();
        if (it >= Q_TOTAL) break;
        if (it < Q_GDN_P) { const int b = it >> 2, h = it & 3;
            gdn_chunk_item(p, L, b, h, p.out + O_GDN_P + (size_t)it * 16384, tid, wave, lane); continue; }
        it -= Q_GDN_P;
        if (it < Q_GDN_S) { const int b = it >> 2, h = it & 3;
            gdn_item(p, L, MP + b * 16, 16, h, p.in[3] + (size_t)it * 16384, p.in[2] + (size_t)b * 3 * 1536, p.out + O_GDN_S + (size_t)it * 16384, tid, wave, lane); continue; }
        it -= Q_GDN_S;
        if (it < Q_ATT_S) { attn_sample_item(p, L, it >> 3, it & 7, tid, wave, lane); continue; }
        it -= Q_ATT_S;
        attn_prompt_item(p, L, it >> 5, it & 31, wave, lane);
    }
}

#define XB_TMO      128
#define XB_XCNT(j)  (256  + 64 * (j))
#define XB_XSUB(j)  (1280 + 64 * (j))
#define XB_XGEN(j)  (2304 + 64 * (j))
#define XB_TOP      3328
#define XB_TOPGEN   3392
#define XCD_BAR_WORDS 3456
#define XB_SPIN_CAP (1u << 18)

__device__ __forceinline__ unsigned xb_ld(unsigned* p)              { return __hip_atomic_load(p, __ATOMIC_RELAXED, __HIP_MEMORY_SCOPE_AGENT); }
__device__ __forceinline__ unsigned xb_add(unsigned* p, unsigned v) { return __hip_atomic_fetch_add(p, v, __ATOMIC_RELAXED, __HIP_MEMORY_SCOPE_AGENT); }
__device__ __forceinline__ unsigned xb_xcc_id() { return (unsigned)__builtin_amdgcn_s_getreg((3 << 11) | 20) & 0xFu; }
#define XB_SPIN(cond, bar) do { unsigned _sp = 0; while (cond) { __builtin_amdgcn_s_sleep(1); \
    if ((++_sp & 255u) == 0u) { if (xb_ld(&(bar)[XB_TMO])) break; if (_sp > XB_SPIN_CAP) { atomicAdd(&(bar)[XB_TMO], 1u); break; } } } } while (0)

struct XcdBarrier {
    unsigned* bar; unsigned x;
    volatile LAS unsigned* st;
};

__device__ __forceinline__ XcdBarrier xcd_barrier_post(unsigned* bar, volatile LAS unsigned* st) {
    XcdBarrier b; b.bar = bar; b.x = xb_xcc_id(); b.st = st;
    if (threadIdx.x == 0) (void)xb_add(&bar[XB_XCNT(b.x)], 1u);
    return b;
}
__device__ __forceinline__ void xcd_barrier_complete(unsigned* bar, unsigned x, unsigned& nloc, unsigned& nx) {
    const unsigned G = gridDim.x * gridDim.y * gridDim.z;
    unsigned sum, cnt, mine, sp = 0u;
    for (;;) {
        sum = 0u; cnt = 0u; mine = 0u;
#pragma unroll
        for (unsigned j = 0; j < 16; ++j) { const unsigned c = xb_ld(&bar[XB_XCNT(j)]); sum += c; cnt += (c > 0u) ? 1u : 0u; mine = (j == x) ? c : mine; }
        if (sum == G) break;
        __builtin_amdgcn_s_sleep(1);
        if ((++sp & 255u) == 0u) { if (xb_ld(&bar[XB_TMO])) break; if (sp > XB_SPIN_CAP) { atomicAdd(&bar[XB_TMO], 1u); break; } }
    }
    nloc = mine > 0u ? mine : 1u; nx = cnt > 0u ? cnt : 1u;
}

__device__ __forceinline__ void xcd_barrier(const XcdBarrier& b) {
    asm volatile("s_waitcnt vmcnt(0)" ::: "memory");
    __syncthreads();
    if (threadIdx.x == 0) {
        unsigned* bar = b.bar;
        __builtin_amdgcn_s_waitcnt(0);
        unsigned nloc = b.st[0], nx = b.st[1];
        if (nloc == 0u) { xcd_barrier_complete(bar, b.x, nloc, nx); b.st[0] = nloc; b.st[1] = nx; }
        const unsigned old = xb_add(&bar[XB_XSUB(b.x)], 1u);
        const unsigned gen = old / nloc;
        if (old + 1u == (gen + 1u) * nloc) {
            __builtin_amdgcn_fence(__ATOMIC_RELEASE, "agent");
            asm volatile("s_waitcnt vmcnt(0)" ::: "memory");
            const unsigned og = xb_add(&bar[XB_TOP], 1u);
            const unsigned tg = og / nx;
            if (og + 1u == (tg + 1u) * nx) xb_add(&bar[XB_TOPGEN], 1u);
            else XB_SPIN(xb_ld(&bar[XB_TOPGEN]) == tg, bar);
            __builtin_amdgcn_fence(__ATOMIC_ACQUIRE, "agent");
            xb_add(&bar[XB_XGEN(b.x)], 1u);
            asm volatile("s_waitcnt vmcnt(0)" ::: "memory");
        } else {
            XB_SPIN(xb_ld(&bar[XB_XGEN(b.x)]) == gen, bar);
            __builtin_amdgcn_fence(__ATOMIC_ACQUIRE, "agent");
            asm volatile("s_waitcnt vmcnt(0)" ::: "memory");
        }
    }
    __syncthreads();
}

__global__ void __launch_bounds__(NTHREADS, 2) fwd_megakernel(Params p) {
    extern __shared__ __attribute__((aligned(16))) unsigned char lds_raw[];
    LAS unsigned char* L = (LAS unsigned char*)lds_raw;
    cg::grid_group grid = cg::this_grid();
    const int tid = threadIdx.x, lane = tid & 63, wave = __builtin_amdgcn_readfirstlane(tid >> 6);
    const int G = gridDim.x;
    volatile LAS unsigned* xbst = (volatile LAS unsigned*)(L + LDS_XB);
    if (tid < 2) xbst[tid] = 0u;
    __syncthreads();
    const XcdBarrier xbar = xcd_barrier_post((unsigned*)(p.ws + WS_CTL) + CW_BAR, xbst);
    const bf16_t* H = (const bf16_t*)(p.ws + WS_H);
    const float* MOD = (const float*)(p.ws + WS_MOD);

    grid.sync();
    phase0(p, L, tid, wave, lane);
    xcd_barrier(xbar);
    prepass<true>(p, L, tid, wave, lane);
    xcd_barrier(xbar);
    {
        pg8::Gemm g{H, (const bf16_t*)(p.ws + WS_WIN), M, NPROJ, D}; pg8::StaticOrder S; S.init(M, NPROJ, G, (int)blockIdx.x);
        EpiIn E{(bf16_t*)(p.ws + WS_PROJ), (bf16_t*)(p.ws + WS_VT), p.in[17], p.in[18], p.out, L + 131072};
        pg8::gemm_phase<EpiIn, pg8::StaticOrder, true, true>(L, g, S, E);
    }
    xcd_barrier(xbar);
    phase3(p, L, tid, wave, lane);
    xcd_barrier(xbar);
    {
        pg8::Gemm g{(const bf16_t*)(p.ws + WS_MIX), (const bf16_t*)(p.ws + WS_WOUT), M, D, D}; pg8::StaticOrder S; S.init(M, D, G, (int)blockIdx.x);
        EpiRes<false> E{p.in[0], p.in[1], MOD, 2048, p.out + O_Y, (bf16_t*)(p.ws + WS_X1B)};
        pg8::gemm_phase<EpiRes<false>, pg8::StaticOrder, true, true>(L, g, S, E);
    }
    xcd_barrier(xbar);
    prepass<false>(p, L, tid, wave, lane);
    xcd_barrier(xbar);
    {
        pg8::Gemm g{H, (const bf16_t*)(p.ws + WS_WUP), M, DFF, D}; pg8::StaticOrder S; S.init(M, DFF, G, (int)blockIdx.x);
        EpiUp E{(bf16_t*)(p.ws + WS_PROJ)};
        pg8::gemm_phase<EpiUp, pg8::StaticOrder, true, true>(L, g, S, E);
    }
    xcd_barrier(xbar);
    {
        pg8::Gemm g{(const bf16_t*)(p.ws + WS_PROJ), (const bf16_t*)(p.ws + WS_WDN), M, D, DFF}; pg8::SplitTailOrder S; S.init(MP, D, G, (int)blockIdx.x);
        EpiRes<true> E{nullptr, nullptr, MOD, 5120, p.out + O_Y, (bf16_t*)(p.ws + WS_X1B)};
        pg8::gemm_phase<EpiRes<true>, pg8::SplitTailOrder, true, true>(L, g, S, E);
    }
}

extern "C" void kernel_launch(void* const* d_in, const int* in_sizes, int n_in, void* d_out, int out_size, void* d_ws, size_t ws_size, hipStream_t stream) {
    static int grid = 0;
    if (grid == 0) {
        if (n_in != 23 || ws_size < WS_END) { fprintf(stderr, "kernel_launch: unexpected n_in %d / ws_size %zu\n", n_in, ws_size); grid = -1; return; }
        int dev = 0, cus = 0, per_cu = 0;
        hipGetDevice(&dev);
        hipDeviceGetAttribute(&cus, hipDeviceAttributeMultiprocessorCount, dev);
        if (hipFuncSetAttribute((const void*)fwd_megakernel, hipFuncAttributeMaxDynamicSharedMemorySize, LDS_BYTES) != hipSuccess) { fprintf(stderr, "kernel_launch: hipFuncSetAttribute failed\n"); grid = -1; return; }
        if (hipOccupancyMaxActiveBlocksPerMultiprocessor(&per_cu, (const void*)fwd_megakernel, NTHREADS, LDS_BYTES) != hipSuccess || per_cu < 1) { fprintf(stderr, "kernel_launch: occupancy query failed (%d)\n", per_cu); per_cu = 1; (void)hipGetLastError(); }
        grid = cus * per_cu;
    }
    if (grid < 0) return;
    (void)hipMemsetAsync((char*)d_ws + WS_CTL, 0, 65536, stream);
    Params p{};
    for (int i = 0; i < 23; ++i) p.in[i] = (const float*)d_in[i];
    p.out = (float*)d_out; p.ws = (unsigned char*)d_ws;
    void* args[] = {&p};
    hipError_t e = hipLaunchCooperativeKernel((const void*)fwd_megakernel, dim3(grid), dim3(NTHREADS), args, LDS_BYTES, stream);
    if (e != hipSuccess) fprintf(stderr, "kernel_launch: cooperative launch failed: %s (grid %d)\n", hipGetErrorString(e), grid);
}
```
